# Optimizing an MI355X kernel written in HIP

```python
import jax, jax.numpy as jnp
from jax import lax
import numpy as np

D_MODEL = 2048
BATCH = 8
SEQ = 2048
DEPTH = 4

GRID_W = 64
CTX_LEN = 256
HEAD_DIM = 64
MIX_WIDTH = D_MODEL
LRU_WIDTH = MIX_WIDTH // 4
LRU_BLOCKS = LRU_WIDTH // HEAD_DIM
LRU_CONV = 4
LRU_CONV_PAD = 2
LRU_C = 8.0
NA_WIDTH = MIX_WIDTH // 2
NA_HEADS = NA_WIDTH // HEAD_DIM
NA_ROWS = 8
NA_KC = 16
NA_QC = 16
NA_SPAN = NA_QC + NA_KC
ROPE_BASE = 10000.0
ROPE_FREQS = HEAD_DIM // 4
SGU_WIDTH = MIX_WIDTH - LRU_WIDTH - NA_WIDTH
SGU_GROUPS = SGU_WIDTH // HEAD_DIM
SGU_CHUNK = 128
PROJ_WIDTH = 2 * LRU_WIDTH + 3 * NA_WIDTH + 2 * SGU_WIDTH
FFN_HIDDEN = 5504
FFN_CONV = 3
NORM_EPS = 1e-6
NEG_INF = -1e30

kernel_name = 'hybrid_lru_natten_sgu_dit'


def rmsnorm(x, g):
    xf = x.astype(jnp.float32)
    y = xf * lax.rsqrt(jnp.mean(xf * xf, axis=-1, keepdims=True) + NORM_EPS)
    return (y * g.astype(jnp.float32)).astype(x.dtype)


def layernorm(x, g, b):
    xf = x.astype(jnp.float32)
    mu = jnp.mean(xf, axis=-1, keepdims=True)
    var = jnp.mean(jnp.square(xf - mu), axis=-1, keepdims=True)
    return ((xf - mu) * lax.rsqrt(var + NORM_EPS) * g.astype(jnp.float32) + b.astype(jnp.float32)).astype(x.dtype)


def adaln(cvec, w, b):
    return jnp.split(jax.nn.silu(cvec) @ w + b, 6, axis=-1)


def modulate(h, shift, scale):
    return h * (1 + scale) + shift


def dwconv(x, w, b, pad_left):
    K, T = w.shape[0], x.shape[1]
    xp = jnp.pad(x, ((0, 0), (pad_left, K - 1 - pad_left), (0, 0)))
    y = b
    for k in range(K):
        y = y + xp[:, k:k + T] * w[k]
    return y


def split_proj(z):
    a = LRU_WIDTH
    idx = [a, 2 * a, 2 * a + NA_WIDTH, 2 * a + 2 * NA_WIDTH, 2 * a + 3 * NA_WIDTH,
           2 * a + 3 * NA_WIDTH + SGU_WIDTH]
    return jnp.split(z, idx, axis=-1)


def to_heads(t):
    return t.reshape(t.shape[0], t.shape[1], NA_HEADS, HEAD_DIM)


def rglru_coeffs(x, gate_w, gate_b, lam):
    B, T, W = x.shape
    xg = x.reshape(B, T, LRU_BLOCKS, HEAD_DIM)
    g = jnp.einsum('btgi,kgio->kbtgo', xg, gate_w).reshape(2, B, T, W) + gate_b[:, None, None, :]
    r = jax.nn.sigmoid(g[0].astype(jnp.float32))
    i = jax.nn.sigmoid(g[1].astype(jnp.float32))
    log_a = -LRU_C * jax.nn.softplus(-lam.astype(jnp.float32)) * r
    a = jnp.exp(log_a)
    b = jnp.sqrt(-jnp.expm1(2.0 * log_a)) * (i * x.astype(jnp.float32))
    return a, b


def _lin_combine(left, right):
    a_l, b_l = left
    a_r, b_r = right
    return a_l * a_r, a_r * b_l + b_r


def linear_scan(a, b, h0, reverse):
    if reverse:
        a, b = jnp.flip(a, 1), jnp.flip(b, 1)
    b = b.at[:, 0].add(a[:, 0] * h0)
    _, h = lax.associative_scan(_lin_combine, (a, b), axis=1)
    return jnp.flip(h, 1) if reverse else h


def rglru_mixer(xl, yl, xc, yc, conv_w, conv_b, gate_w, gate_b, lam, need_ctx):
    xl = dwconv(xl, conv_w, conv_b, LRU_CONV_PAD)
    xc = dwconv(xc, conv_w, conv_b, LRU_CONV_PAD)
    B, _, W = xc.shape
    h_lat, h_ctx = [], []
    for d in range(2):
        rev = d == 1
        a_c, b_c = rglru_coeffs(xc, gate_w[d], gate_b[d], lam[d])
        hc = linear_scan(a_c, b_c, jnp.zeros((B, W), jnp.float32), rev)
        h_final = hc[:, 0] if rev else hc[:, -1]
        a_l, b_l = rglru_coeffs(xl, gate_w[d], gate_b[d], lam[d])
        h_lat.append(linear_scan(a_l, b_l, h_final, rev))
        h_ctx.append(hc)
    out_l = (h_lat[0] + h_lat[1]).astype(xl.dtype) * jax.nn.gelu(yl)
    if not need_ctx:
        return out_l, None
    out_c = (h_ctx[0] + h_ctx[1]).astype(xc.dtype) * jax.nn.gelu(yc)
    return out_l, out_c


def rope2d_tables(S):
    t = jnp.arange(S)
    pos = jnp.stack([t // GRID_W, t % GRID_W], axis=-1).astype(jnp.float32)
    inv = ROPE_BASE ** (-jnp.arange(ROPE_FREQS, dtype=jnp.float32) / ROPE_FREQS)
    ang = pos[:, :, None] * inv
    return jnp.cos(ang), jnp.sin(ang)


def rope2d(x, cos, sin):
    B, S, H, dh = x.shape
    xr = x.reshape(B, S, H, 2, 2, ROPE_FREQS)
    x1, x2 = xr[..., 0, :], xr[..., 1, :]
    cs = cos[None, :, None].astype(x.dtype)
    sn = sin[None, :, None].astype(x.dtype)
    return jnp.stack([x1 * cs - x2 * sn, x2 * cs + x1 * sn], axis=-2).reshape(B, S, H, dh)


def neighbourhood_attention(q, k, v, k_ctx, v_ctx, rpb, cos, sin):
    B, S, H, dh = q.shape
    rows = S // GRID_W
    kr = min(NA_ROWS, rows)
    scale = dh ** -0.5
    grid = lambda t: t.reshape(B, rows, GRID_W, H, dh)
    q_rot, k_g, v_g, q_raw = grid(rope2d(q, cos, sin)), grid(rope2d(k, cos, sin)), grid(v), grid(q)
    r_idx = jnp.arange(rows)
    row_start = jnp.clip(r_idx - kr // 2, 0, rows - kr)
    key_rows = row_start[:, None] + jnp.arange(kr)[None, :]
    rel_r = key_rows - r_idx[:, None] + (NA_ROWS - 1)
    n_win = kr * NA_SPAN

    def block(j):
        c0 = j * NA_QC
        q_cols = c0 + jnp.arange(NA_QC)
        col_start = jnp.clip(q_cols - NA_KC // 2, 0, GRID_W - NA_KC)
        key_cols = jnp.clip(c0 - NA_KC // 2, 0, GRID_W - NA_SPAN) + jnp.arange(NA_SPAN)
        in_win = (key_cols[None, :] >= col_start[:, None]) & (key_cols[None, :] < col_start[:, None] + NA_KC)
        rel_c = jnp.clip(key_cols[None, :] - q_cols[:, None] + (NA_KC - 1), 0, 2 * NA_KC - 2)
        kb = k_g[:, key_rows[:, :, None], key_cols[None, None, :]]
        vb = v_g[:, key_rows[:, :, None], key_cols[None, None, :]]
        qb = lax.dynamic_slice_in_dim(q_rot, c0, NA_QC, axis=2)
        qb_raw = lax.dynamic_slice_in_dim(q_raw, c0, NA_QC, axis=2)
        bias = rpb[:, rel_r[:, None, :, None], rel_c[None, :, None, :]]
        s_win = jnp.einsum('brqhd,brkmhd->bhrqkm', qb, kb).astype(jnp.float32) * scale
        s_win = s_win + bias[None].astype(jnp.float32)
        s_win = jnp.where(in_win[:, None, :], s_win, NEG_INF).reshape(B, H, rows, NA_QC, n_win)
        s_ctx = jnp.einsum('brqhd,blhd->bhrql', qb_raw, k_ctx).astype(jnp.float32) * scale
        p = jax.nn.softmax(jnp.concatenate([s_win, s_ctx], axis=-1), axis=-1).astype(v.dtype)
        o = jnp.einsum('bhrqk,brkhd->brqhd', p[..., :n_win], vb.reshape(B, rows, n_win, H, dh))
        return o + jnp.einsum('bhrql,blhd->brqhd', p[..., n_win:], v_ctx)

    o = lax.map(block, jnp.arange(GRID_W // NA_QC))
    return jnp.moveaxis(o, 0, 2).reshape(B, S, H * dh)


def context_attention(q, k, v):
    B, L, H, dh = q.shape
    s = jnp.einsum('blhd,bmhd->bhlm', q, k).astype(jnp.float32) * (dh ** -0.5)
    p = jax.nn.softmax(s, axis=-1).astype(v.dtype)
    return jnp.einsum('bhlm,bmhd->blhd', p, v).reshape(B, L, H * dh)


def spatial_gating(u, v, ln_g, ln_b, w_s, b_s):
    u = jax.nn.gelu(u)
    v = layernorm(jax.nn.gelu(v), ln_g, ln_b)
    B, T, _ = v.shape
    vg = v.reshape(B, T // SGU_CHUNK, SGU_CHUNK, SGU_GROUPS, HEAD_DIM)
    mixed = jnp.einsum('gpq,bnqgd->bnpgd', w_s, vg) + b_s.T[None, None, :, :, None]
    return u * mixed.reshape(B, T, SGU_WIDTH)


def hybrid_mixer(hx, hc, w_in, lru_conv_w, lru_conv_b, lru_gate_w, lru_gate_b, lru_lambda,
                 na_rpb, sgu_ln_g, sgu_ln_b, sgu_w, sgu_b, cos, sin, need_ctx):
    ax, ay, q, k, v, su, sv = split_proj(hx @ w_in)
    cax, cay, cq, ck, cv, csu, csv = split_proj(hc @ w_in)
    ck_h, cv_h = to_heads(ck), to_heads(cv)
    out_a, cout_a = rglru_mixer(ax, ay, cax, cay, lru_conv_w, lru_conv_b, lru_gate_w, lru_gate_b,
                                lru_lambda, need_ctx)
    out_b = neighbourhood_attention(to_heads(q), to_heads(k), to_heads(v), ck_h, cv_h, na_rpb, cos, sin)
    out_c = spatial_gating(su, sv, sgu_ln_g, sgu_ln_b, sgu_w, sgu_b)
    mix_x = jnp.concatenate([out_a, out_b, out_c], axis=-1)
    if not need_ctx:
        return mix_x, None
    cout_b = context_attention(to_heads(cq), ck_h, cv_h)
    cout_c = spatial_gating(csu, csv, sgu_ln_g, sgu_ln_b, sgu_w, sgu_b)
    return mix_x, jnp.concatenate([cout_a, cout_b, cout_c], axis=-1)


def conv_ffn(h, w_up, conv_w, conv_b, w_down):
    u = dwconv(h @ w_up, conv_w, conv_b, 1)
    a, g = jnp.split(u, 2, axis=-1)
    return (jax.nn.silu(g) * a) @ w_down


def setup_inputs(seed: int = 0) -> dict:
    key = jax.random.key(seed)
    ks = jax.random.split(key, 26)
    D = D_MODEL
    nrm = lambda k, shape, s: jax.random.normal(k, shape, jnp.float32) * s
    a_pow = jax.random.uniform(ks[14], (DEPTH, 2, LRU_WIDTH), jnp.float32, 0.9, 0.999)
    sig = a_pow ** (1.0 / LRU_C)
    return {
        'x': nrm(ks[0], (BATCH, SEQ, D), 1.0),
        'c': nrm(ks[1], (BATCH, D), 1.0),
        'ctx': nrm(ks[2], (BATCH, CTX_LEN, D), 1.0),
        'c_ctx': nrm(ks[3], (D,), 1.0),
        'w_ada': nrm(ks[4], (DEPTH, D, 6 * D), 0.5 * D ** -0.5),
        'b_ada': nrm(ks[5], (DEPTH, 6 * D), 0.01),
        'norm_mix_g': 1.0 + nrm(ks[6], (DEPTH, D), 0.02),
        'norm_ffn_g': 1.0 + nrm(ks[7], (DEPTH, D), 0.02),
        'w_in': nrm(ks[8], (DEPTH, D, PROJ_WIDTH), D ** -0.5),
        'lru_conv_w': nrm(ks[9], (DEPTH, LRU_CONV, LRU_WIDTH), LRU_CONV ** -0.5),
        'lru_conv_b': nrm(ks[10], (DEPTH, LRU_WIDTH), 0.01),
        'lru_gate_w': nrm(ks[11], (DEPTH, 2, 2, LRU_BLOCKS, HEAD_DIM, HEAD_DIM), HEAD_DIM ** -0.5),
        'lru_gate_b': nrm(ks[12], (DEPTH, 2, 2, LRU_WIDTH), 0.01),
        'lru_lambda': jnp.log(sig) - jnp.log1p(-sig),
        'na_rpb': nrm(ks[15], (DEPTH, NA_HEADS, 2 * NA_ROWS - 1, 2 * NA_KC - 1), 0.1),
        'sgu_ln_g': 1.0 + nrm(ks[16], (DEPTH, SGU_WIDTH), 0.02),
        'sgu_ln_b': nrm(ks[17], (DEPTH, SGU_WIDTH), 0.01),
        'sgu_w': nrm(ks[18], (DEPTH, SGU_GROUPS, SGU_CHUNK, SGU_CHUNK), 0.5 * SGU_CHUNK ** -0.5),
        'sgu_b': 1.0 + nrm(ks[19], (DEPTH, SGU_GROUPS, SGU_CHUNK), 0.01),
        'w_out': nrm(ks[20], (DEPTH, MIX_WIDTH, D), MIX_WIDTH ** -0.5),
        'ffn_up': nrm(ks[21], (DEPTH, D, 2 * FFN_HIDDEN), D ** -0.5),
        'ffn_conv_w': nrm(ks[22], (DEPTH, FFN_CONV, 2 * FFN_HIDDEN), FFN_CONV ** -0.5),
        'ffn_conv_b': nrm(ks[23], (DEPTH, 2 * FFN_HIDDEN), 0.01),
        'ffn_down': nrm(ks[24], (DEPTH, FFN_HIDDEN, D), FFN_HIDDEN ** -0.5),
        'final_norm_g': 1.0 + nrm(ks[25], (D,), 0.02),
    }


def reference(x, c, ctx, c_ctx, w_ada, b_ada, norm_mix_g, norm_ffn_g, w_in, lru_conv_w, lru_conv_b,
              lru_gate_w, lru_gate_b, lru_lambda, na_rpb, sgu_ln_g, sgu_ln_b, sgu_w, sgu_b, w_out,
              ffn_up, ffn_conv_w, ffn_conv_b, ffn_down, final_norm_g):
    cos, sin = rope2d_tables(x.shape[1])
    for i in range(DEPTH):
        need_ctx = i < DEPTH - 1
        sh_a, sc_a, g_a, sh_f, sc_f, g_f = adaln(c, w_ada[i], b_ada[i])
        csh_a, csc_a, cg_a, csh_f, csc_f, cg_f = adaln(c_ctx, w_ada[i], b_ada[i])
        hx = modulate(rmsnorm(x, norm_mix_g[i]), sh_a[:, None], sc_a[:, None])
        hc = modulate(rmsnorm(ctx, norm_mix_g[i]), csh_a, csc_a)
        mix_x, mix_c = hybrid_mixer(hx, hc, w_in[i], lru_conv_w[i], lru_conv_b[i], lru_gate_w[i],
                                    lru_gate_b[i], lru_lambda[i], na_rpb[i], sgu_ln_g[i], sgu_ln_b[i],
                                    sgu_w[i], sgu_b[i], cos, sin, need_ctx)
        x = x + g_a[:, None] * (mix_x @ w_out[i])
        hx = modulate(rmsnorm(x, norm_ffn_g[i]), sh_f[:, None], sc_f[:, None])
        x = x + g_f[:, None] * conv_ffn(hx, ffn_up[i], ffn_conv_w[i], ffn_conv_b[i], ffn_down[i])
        if need_ctx:
            ctx = ctx + cg_a * (mix_c @ w_out[i])
            hc = modulate(rmsnorm(ctx, norm_ffn_g[i]), csh_f, csc_f)
            ctx = ctx + cg_f * conv_ffn(hc, ffn_up[i], ffn_conv_w[i], ffn_conv_b[i], ffn_down[i])
    return rmsnorm(x, final_norm_g)
```

```cpp
#include <hip/hip_runtime.h>
#include <cstdio>
#include <cstdint>
namespace pg8 {
#define PG8_LAS __attribute__((address_space(3)))
typedef unsigned short bf16_t;
typedef short bf16x8 __attribute__((ext_vector_type(8)));
typedef float f32x4 __attribute__((ext_vector_type(4)));
typedef unsigned u32x4 __attribute__((ext_vector_type(4)));
constexpr int BM = 256, BK = 64, HALF = 128, HTB = HALF * BK * 2  , STAGE_BYTES = 8 * HTB, NXCD = 8, WGM = 8;

__host__ __device__ __forceinline__ int lds_byte(int r, int c) { const int st = (r >> 4) * 2 + (c >> 5), rr = r & 15, cc = c & 31, ob = rr * 64 + cc * 2; return st * 1024 + (ob ^ (((ob >> 9) & 1) << 5)); }
__host__ __device__ __forceinline__ void stage_rc(int b, int& R, int& C) { const int st = b / 1024, sb = b % 1024, swz = sb ^ (((sb >> 9) & 1) << 5); R = (st >> 1) * 16 + swz / 64; C = (st & 1) * 32 + (swz % 64) / 2; }
__host__ __device__ __forceinline__ int perm32(int rho) { const int n = rho >> 4, i = rho & 15; return 8 * (i >> 2) + 4 * n + (i & 3); }

struct Unit { int pm, pn; };
struct Gemm { const bf16_t* A; const bf16_t* Bt; int M, N, K; };

struct StaticOrder {
    int nM, nN, nwg, G, c;
    __host__ __device__ void init(int M, int N, int G_, int c_) { nM = M / BM; nN = N / BM; nwg = nM * nN; G = G_; c = c_; }
    __host__ __device__ bool next(int i, Unit& u) const {
        const long L = (long)i * G + c; if (L >= nwg) return false;
        int wgid = (int)L; { const int q = nwg / NXCD, r = nwg % NXCD, xcd = wgid % NXCD, off = wgid / NXCD; wgid = (xcd < r ? xcd * (q + 1) : r * (q + 1) + (xcd - r) * q) + off; }
        const int nig = WGM * nN, gid = wgid / nig, fm = gid * WGM, gsz = (nM - fm) < WGM ? (nM - fm) : WGM;
        u.pm = fm + ((wgid % nig) % gsz); u.pn = (wgid % nig) / gsz; return true;
    }
    __device__ __forceinline__ void a_ready(const Unit&) const {}
    __device__ __forceinline__ void done(const Unit&) const {}
};

__device__ __forceinline__ unsigned cvt_pk_bf16(float lo, float hi) { unsigned r; asm volatile("v_cvt_pk_bf16_f32 %0, %1, %2" : "=v"(r) : "v"(lo), "v"(hi)); return r; }
typedef float f32x2 __attribute__((ext_vector_type(2)));
__device__ __forceinline__ f32x2 gelu_pk(f32x2 v) {
    const f32x2 av = __builtin_elementwise_abs(v), d = av * 0.2316418882f + 1.0f;
    f32x2 t; t.x = __builtin_amdgcn_rcpf(d.x); t.y = __builtin_amdgcn_rcpf(d.y);
    f32x2 q = t * 0.5307027145f + (-0.7265760135f); q = q * t + 0.7107068705f; q = q * t + (-0.142248368f); q = q * t + 0.127414796f; q = q * t;
    const f32x2 s = (v * v) * (-0.72134752044f);
    f32x2 e; e.x = __builtin_amdgcn_exp2f(s.x); e.y = __builtin_amdgcn_exp2f(s.y);
    const f32x2 m = v * (q * e), r = v - m;
    f32x2 o; o.x = v.x < 0.f ? m.x : r.x; o.y = v.y < 0.f ? m.y : r.y; return o;
}

template <int ACT  > struct EpiBf16 {
    static constexpr bool PERM = true, AFTER_DRAIN = false; static_assert(ACT == 0 || ACT == 1, "EpiBf16: ACT is 0 (none) or 1 (gelu_pk)");
    bf16_t* O; int ldc; const float* bias; int split_cols; size_t split_stride; float scale0;
    __device__ __forceinline__ void operator()(const f32x4 (&acc)[2][2][4][2], const Unit& u, int wr, int wc, int fr, int fq) const {
        const int row0 = u.pm * BM + wr * 64 + fr; int colt = u.pn * BM; bf16_t* base = O;
        float sc = 1.f; if (split_cols) { const int t = colt / split_cols; base += (size_t)t * split_stride; colt -= t * split_cols; if (t == 0) sc = scale0; }
        const int col0 = colt + wc * 32 + 8 * fq, bcol0 = u.pn * BM + wc * 32 + 8 * fq;
        f32x4 bv[2][2];
#pragma unroll
        for (int bj = 0; bj < 2; ++bj)
#pragma unroll
            for (int n = 0; n < 2; ++n) bv[bj][n] = bias ? *(const f32x4*)(bias + bcol0 + bj * HALF + 4 * n) : (f32x4){0.f, 0.f, 0.f, 0.f};
#pragma unroll
        for (int ai = 0; ai < 2; ++ai)
#pragma unroll
            for (int m = 0; m < 4; ++m) { bf16_t* rowp = base + (size_t)(row0 + ai * HALF + m * 16) * ldc + col0;
#pragma unroll
                for (int bj = 0; bj < 2; ++bj) { f32x4 v0 = acc[ai][bj][m][0] + bv[bj][0], v1 = acc[ai][bj][m][1] + bv[bj][1];
                    if (ACT == 1) { f32x2 a = gelu_pk((f32x2){v0[0], v0[1]}), b = gelu_pk((f32x2){v0[2], v0[3]}), c = gelu_pk((f32x2){v1[0], v1[1]}), d = gelu_pk((f32x2){v1[2], v1[3]});
                        v0 = (f32x4){a.x, a.y, b.x, b.y}; v1 = (f32x4){c.x, c.y, d.x, d.y}; }
                    v0 = v0 * sc; v1 = v1 * sc; u32x4 w; w.x = cvt_pk_bf16(v0[0], v0[1]); w.y = cvt_pk_bf16(v0[2], v0[3]); w.z = cvt_pk_bf16(v1[0], v1[1]); w.w = cvt_pk_bf16(v1[2], v1[3]);
                    *(u32x4*)(rowp + bj * HALF) = w; } }
    }
};

struct EpiResGate {
    static constexpr bool PERM = false, AFTER_DRAIN = false;
    const float* base_lat; const float* base_ctx;
    float* out; const float* gate;
    __device__ __forceinline__ void operator()(const f32x4 (&acc)[2][2][4][2], const Unit& u, int wr, int wc, int fr, int fq) const {
        const int row0 = u.pm * BM + wr * 64 + fr, col0 = u.pn * BM + wc * 32 + 4 * fq;
        const int v = u.pm < 64 ? (u.pm >> 3) : 8;
        const float* gp = gate + (size_t)v * 12288 + col0;
        const float* base = u.pm < 64 ? base_lat : base_ctx;
        f32x4 gv[2][2];
#pragma unroll
        for (int bj = 0; bj < 2; ++bj)
#pragma unroll
            for (int n = 0; n < 2; ++n) gv[bj][n] = *(const f32x4*)(gp + bj * HALF + n * 16);
#pragma unroll
        for (int ai = 0; ai < 2; ++ai)
#pragma unroll
            for (int m = 0; m < 4; ++m) { const size_t off = (size_t)(row0 + ai * HALF + m * 16) * 2048 + col0;
#pragma unroll
                for (int bj = 0; bj < 2; ++bj)
#pragma unroll
                    for (int n = 0; n < 2; ++n) { const f32x4 b = *(const f32x4*)(base + off + bj * HALF + n * 16);
                        *(f32x4*)(out + off + bj * HALF + n * 16) = b + gv[bj][n] * acc[ai][bj][m][n]; } }
    }
};

struct EpiResGateB16 {
    static constexpr bool PERM = true, AFTER_DRAIN = false;
    const float* base32_lat; const float* base32_ctx;
    const bf16_t* base16; bf16_t* out; const float* gate;
    __device__ __forceinline__ void operator()(const f32x4 (&acc)[2][2][4][2], const Unit& u, int wr, int wc, int fr, int fq) const {
        const int row0 = u.pm * BM + wr * 64 + fr, col0 = u.pn * BM + wc * 32 + 8 * fq;
        const int v = u.pm < 64 ? (u.pm >> 3) : 8;
        const float* gp = gate + (size_t)v * 12288 + col0;
        const float* b32 = u.pm < 64 ? base32_lat : base32_ctx;
        f32x4 gv[2][2];
#pragma unroll
        for (int bj = 0; bj < 2; ++bj)
#pragma unroll
            for (int n = 0; n < 2; ++n) gv[bj][n] = *(const f32x4*)(gp + bj * HALF + 4 * n);
#pragma unroll
        for (int ai = 0; ai < 2; ++ai)
#pragma unroll
            for (int m = 0; m < 4; ++m) { const size_t off = (size_t)(row0 + ai * HALF + m * 16) * 2048 + col0;
#pragma unroll
                for (int bj = 0; bj < 2; ++bj) {
                    f32x4 b0, b1;
                    if (b32) { b0 = *(const f32x4*)(b32 + off + bj * HALF); b1 = *(const f32x4*)(b32 + off + bj * HALF + 4); }
                    else { const u32x4 w = *(const u32x4*)(base16 + off + bj * HALF);
                        b0 = (f32x4){__builtin_bit_cast(float, w.x << 16), __builtin_bit_cast(float, w.x & 0xffff0000u), __builtin_bit_cast(float, w.y << 16), __builtin_bit_cast(float, w.y & 0xffff0000u)};
                        b1 = (f32x4){__builtin_bit_cast(float, w.z << 16), __builtin_bit_cast(float, w.z & 0xffff0000u), __builtin_bit_cast(float, w.w << 16), __builtin_bit_cast(float, w.w & 0xffff0000u)}; }
                    const f32x4 v0 = b0 + gv[bj][0] * acc[ai][bj][m][0], v1 = b1 + gv[bj][1] * acc[ai][bj][m][1];
                    u32x4 o; o.x = cvt_pk_bf16(v0[0], v0[1]); o.y = cvt_pk_bf16(v0[2], v0[3]); o.z = cvt_pk_bf16(v1[0], v1[1]); o.w = cvt_pk_bf16(v1[2], v1[3]);
                    *(u32x4*)(out + off + bj * HALF) = o; } }
    }
};

template <class Epi, class Sched, bool ALIGN_EPI = false, bool SP2 = false>
__device__ __forceinline__ void gemm_phase(PG8_LAS unsigned char* lds, const Gemm g, const Sched& S, const Epi& E, int tid_in) {
    int tid_ = tid_in; asm volatile("" : "+v"(tid_));
    const int tid = tid_, wid = __builtin_amdgcn_readfirstlane(tid >> 6), lane = tid & 63, wr = wid >> 2, wc = wid & 3, fr = lane & 15, fq = lane >> 4;
    const int K = g.K, nt = K / BK;
    unsigned voffA[2], voffB[2];
#pragma unroll
    for (int i = 0; i < 2; ++i) { int R, C; stage_rc(tid * 16 + i * 8192, R, C); const int Rb = Epi::PERM ? ((R & ~31) + perm32(R & 31)) : R;
        voffA[i] = (unsigned)(R * K + C) * 2u; voffB[i] = (unsigned)(Rb * K + C) * 2u; }
    const size_t kstep = (size_t)(BK * 2);
    const size_t hstep = (size_t)HALF * K * 2;
    const size_t tstep = 2 * hstep;
    const unsigned ldsw = (unsigned)wid * 1024u;
    const int aoff = lds_byte(wr * 64 + fr, fq * 8), boff = lds_byte(wc * 32 + fr, fq * 8);
#define PG8_SA(b, h) (((b) * 2 + (h)) * HTB)
#define PG8_SB(b, h) ((4 + (b) * 2 + (h)) * HTB)
#define PG8_STAGE(bufoff, gbase, voff) do { _Pragma("unroll") for (int _i = 0; _i < 2; ++_i) \
        __builtin_amdgcn_global_load_lds((const unsigned*)((const char*)(gbase) + (voff)[_i]), (PG8_LAS unsigned*)(lds + (bufoff) + ldsw + _i * 8192), 16, 0, 0); } while (0)
#define PG8_LDA(dst, b, h) do { _Pragma("unroll") for (int m = 0; m < 4; ++m) _Pragma("unroll") for (int k = 0; k < 2; ++k) dst[m][k] = *(const PG8_LAS bf16x8*)(lds + PG8_SA(b, h) + aoff + m * 2048 + k * 1024); } while (0)
#define PG8_LDB(dst, b, h) do { _Pragma("unroll") for (int n = 0; n < 2; ++n) _Pragma("unroll") for (int k = 0; k < 2; ++k) dst[n][k] = *(const PG8_LAS bf16x8*)(lds + PG8_SB(b, h) + boff + n * 2048 + k * 1024); } while (0)
#define PG8_MMA(ai, bj, At, Bt) do { __builtin_amdgcn_s_setprio(1); _Pragma("unroll") for (int m = 0; m < 4; ++m) _Pragma("unroll") for (int n = 0; n < 2; ++n) _Pragma("unroll") for (int k = 0; k < 2; ++k) \
        acc[ai][bj][m][n] = __builtin_amdgcn_mfma_f32_16x16x32_bf16(Bt[n][k], At[m][k], acc[ai][bj][m][n], 0, 0, 0); __builtin_amdgcn_s_setprio(0); } while (0)
#define PG8_WAIT_V(n) asm volatile("s_waitcnt vmcnt(" #n ")" ::: "memory")
#define PG8_WAIT_L(n) asm volatile("s_waitcnt lgkmcnt(" #n ")" ::: "memory")
#define PG8_BAR __builtin_amdgcn_s_barrier()
#define PG8_SCHED __builtin_amdgcn_sched_barrier(0)
    Unit cur, nxt; int ui = 0;
    if (!S.next(0, cur)) return;
    f32x4 acc[2][2][4][2];
#pragma unroll
    for (int a = 0; a < 2; ++a)
#pragma unroll
        for (int b = 0; b < 2; ++b)
#pragma unroll
            for (int m = 0; m < 4; ++m)
#pragma unroll
                for (int n = 0; n < 2; ++n) acc[a][b][m][n] = (f32x4){0.f, 0.f, 0.f, 0.f};
    bf16x8 At[4][2], B0[2][2], B1[2][2];
    const char* cA = (const char*)g.A + (size_t)cur.pm * tstep; const char* cB = (const char*)g.Bt + (size_t)cur.pn * tstep;
    S.a_ready(cur);
    if constexpr (SP2) {
        PG8_STAGE(PG8_SB(0, 0), cB, voffB); PG8_STAGE(PG8_SB(0, 1), cB + hstep, voffB); PG8_STAGE(PG8_SA(0, 0), cA, voffA); PG8_STAGE(PG8_SA(0, 1), cA + hstep, voffA);
        if (wr == 1) PG8_BAR;
        PG8_WAIT_V(2); PG8_BAR;
        PG8_STAGE(PG8_SB(1, 0), cB + kstep, voffB); PG8_STAGE(PG8_SA(1, 0), cA + kstep, voffA); PG8_STAGE(PG8_SB(1, 1), cB + hstep + kstep, voffB);
        PG8_WAIT_V(6); PG8_BAR;
    } else {
        PG8_STAGE(PG8_SB(0, 0), cB, voffB); PG8_STAGE(PG8_SA(0, 0), cA, voffA); PG8_STAGE(PG8_SB(0, 1), cB + hstep, voffB); PG8_STAGE(PG8_SA(0, 1), cA + hstep, voffA);
        if (wr == 1) PG8_BAR;
        PG8_WAIT_V(4); PG8_BAR;
        PG8_STAGE(PG8_SB(1, 0), cB + kstep, voffB); PG8_STAGE(PG8_SA(1, 0), cA + kstep, voffA); PG8_STAGE(PG8_SB(1, 1), cB + hstep + kstep, voffB);
        PG8_WAIT_V(6); PG8_BAR;
    }
    for (;;) {
        const bool has_next = S.next(ui + 1, nxt);
        const char* nA = has_next ? (const char*)g.A + (size_t)nxt.pm * tstep : cA; const char* nB = has_next ? (const char*)g.Bt + (size_t)nxt.pn * tstep : cB;
        for (int t = 0; t < nt; t += 2) {
            const bool last = (t == nt - 2);
            const char* a1 = cA + (size_t)(t + 1) * kstep;
            const char* a2 = last ? nA : cA + (size_t)(t + 2) * kstep; const char* b2 = last ? nB : cB + (size_t)(t + 2) * kstep;
            const char* a3 = a2 + kstep; const char* b3 = b2 + kstep;
            if (last && has_next) S.a_ready(nxt);
            if constexpr (SP2) {
            PG8_LDB(B0, 0, 0); PG8_LDB(B1, 0, 1); PG8_SCHED; PG8_LDA(At, 0, 0); PG8_STAGE(PG8_SA(1, 1), a1 + hstep, voffA);
            PG8_WAIT_V(8); PG8_WAIT_L(0); PG8_BAR; PG8_MMA(0, 0, At, B0); PG8_MMA(0, 1, At, B1); PG8_BAR; PG8_SCHED;
            PG8_LDA(At, 0, 1); PG8_STAGE(PG8_SB(0, 0), b2, voffB); PG8_STAGE(PG8_SB(0, 1), b2 + hstep, voffB); PG8_STAGE(PG8_SA(0, 0), a2, voffA);
            PG8_WAIT_V(8); PG8_WAIT_L(0); PG8_BAR; PG8_MMA(1, 0, At, B0); PG8_MMA(1, 1, At, B1); PG8_BAR; PG8_SCHED;
            PG8_LDB(B0, 1, 0); PG8_LDB(B1, 1, 1); PG8_SCHED; PG8_LDA(At, 1, 0); PG8_STAGE(PG8_SA(0, 1), a2 + hstep, voffA);
            PG8_WAIT_V(8); PG8_WAIT_L(0); PG8_BAR; PG8_MMA(0, 0, At, B0); PG8_MMA(0, 1, At, B1); PG8_BAR; PG8_SCHED;
            PG8_LDA(At, 1, 1); PG8_STAGE(PG8_SB(1, 0), b3, voffB); PG8_STAGE(PG8_SB(1, 1), b3 + hstep, voffB); PG8_STAGE(PG8_SA(1, 0), a3, voffA);
            PG8_WAIT_V(8); PG8_WAIT_L(0); PG8_BAR; PG8_MMA(1, 0, At, B0); PG8_MMA(1, 1, At, B1); PG8_BAR; PG8_SCHED;
            } else {
            PG8_LDB(B0, 0, 0); PG8_SCHED; PG8_LDA(At, 0, 0); PG8_STAGE(PG8_SA(1, 1), a1 + hstep, voffA);
            PG8_WAIT_L(8); PG8_BAR; PG8_WAIT_L(0); PG8_MMA(0, 0, At, B0); PG8_BAR; PG8_SCHED;
            PG8_LDB(B1, 0, 1); PG8_STAGE(PG8_SB(0, 0), b2, voffB);
            PG8_BAR; PG8_WAIT_L(0); PG8_MMA(0, 1, At, B1); PG8_BAR;
            PG8_LDA(At, 0, 1); PG8_STAGE(PG8_SA(0, 0), a2, voffA);
            PG8_BAR; PG8_WAIT_L(0); PG8_MMA(1, 0, At, B0); PG8_BAR; PG8_SCHED;
            PG8_STAGE(PG8_SB(0, 1), b2 + hstep, voffB);
            PG8_WAIT_V(6); PG8_BAR; PG8_MMA(1, 1, At, B1); PG8_BAR;
            PG8_LDB(B0, 1, 0); PG8_SCHED; PG8_LDA(At, 1, 0); PG8_STAGE(PG8_SA(0, 1), a2 + hstep, voffA);
            PG8_WAIT_L(8); PG8_BAR; PG8_WAIT_L(0); PG8_MMA(0, 0, At, B0); PG8_BAR; PG8_SCHED;
            PG8_LDB(B1, 1, 1); PG8_STAGE(PG8_SB(1, 0), b3, voffB);
            PG8_BAR; PG8_WAIT_L(0); PG8_MMA(0, 1, At, B1); PG8_BAR;
            PG8_LDA(At, 1, 1); PG8_STAGE(PG8_SA(1, 0), a3, voffA);
            PG8_BAR; PG8_WAIT_L(0); PG8_MMA(1, 0, At, B0); PG8_BAR; PG8_SCHED;
            PG8_STAGE(PG8_SB(1, 1), b3 + hstep, voffB);
            PG8_WAIT_V(6); PG8_BAR; PG8_MMA(1, 1, At, B1); PG8_BAR;
            }
        }
        if constexpr (ALIGN_EPI) { if (wr == 0) PG8_BAR; }
        if constexpr (!Epi::AFTER_DRAIN) { E(acc, cur, wr, wc, fr, fq); S.done(cur); }
        if (!has_next) break;
#pragma unroll
        for (int a = 0; a < 2; ++a)
#pragma unroll
            for (int b = 0; b < 2; ++b)
#pragma unroll
                for (int m = 0; m < 4; ++m)
#pragma unroll
                    for (int n = 0; n < 2; ++n) acc[a][b][m][n] = (f32x4){0.f, 0.f, 0.f, 0.f};
        cur = nxt; cA = nA; cB = nB; ++ui;
        if constexpr (ALIGN_EPI) { if (wr == 1) PG8_BAR; }
    }
    PG8_WAIT_V(0);
    if constexpr (!ALIGN_EPI) { if (wr == 0) PG8_BAR; }
    PG8_BAR;
    if constexpr (Epi::AFTER_DRAIN) { E.fused(acc, cur, wr, wc, fr, fq, lds, wid, lane); S.done(cur); }
#undef PG8_SA
#undef PG8_SB
#undef PG8_STAGE
#undef PG8_LDA
#undef PG8_LDB
#undef PG8_MMA
#undef PG8_WAIT_V
#undef PG8_WAIT_L
#undef PG8_BAR
#undef PG8_SCHED
}
}

constexpr int NWAVES = 8, NTHREADS = 512;
constexpr int NB = 8, SEQ = 2048, DM = 2048, DEPTH = 4, CTXL = 256;
constexpr int MLAT = NB * SEQ, MCTX = NB * CTXL, MALL = MLAT + MCTX;
constexpr int PW = 5120, FH = 5504, FU = 2 * FH, NH = 16, MODW = 6 * DM;
constexpr int ZC_AX = 0, ZC_AY = 512, ZC_Q = 1024, ZC_K = 2048, ZC_V = 3072, ZC_SU = 4096, ZC_SV = 4608;
constexpr float NORM_EPS = 1e-6f;
constexpr int NCHUNK = MALL / 64;

constexpr size_t MiB = 1u << 20;
constexpr size_t WS_CTL = 0, CTL_ZERO_BYTES = 1 * MiB;
constexpr size_t WS_MOD = 1 * MiB;
constexpr size_t WS_GWT = 3 * MiB;
constexpr size_t WS_SWB = 4 * MiB;
constexpr size_t WS_AGG = 5 * MiB;
constexpr size_t WS_ROPE = 7 * MiB + 512 * 1024;
constexpr size_t WS_AGT = 1288 * MiB;
constexpr size_t WS_WT = 8 * MiB;
constexpr size_t WT_IN = 0, WT_OUT = (size_t)PW * DM * 2, WT_UP = WT_OUT + (size_t)DM * DM * 2, WT_DN = WT_UP + (size_t)FU * DM * 2, WT_LAYER = WT_DN + (size_t)DM * FH * 2;
static_assert(WT_LAYER == 96993280, "weights per layer");
constexpr size_t WS_X = 378 * MiB;
constexpr size_t WS_HX = 522 * MiB;
constexpr size_t WS_ACT = 594 * MiB;
constexpr size_t WS_R1 = 788 * MiB;
constexpr size_t WS_Z = WS_R1;
constexpr size_t WS_MIX = WS_R1 + 180 * MiB;
constexpr size_t WS_AB = WS_R1 + 252 * MiB;
constexpr size_t WS_U = WS_R1;
constexpr size_t WS_QR = 1184 * MiB, WS_KR = 1216 * MiB, WS_VT = 1248 * MiB, WS_KC = 1280 * MiB, WS_VTC = 1284 * MiB, WS_END = 1298 * MiB;
static_assert(WS_WT + 4 * WT_LAYER <= WS_X && WS_ACT + (size_t)MALL * FH * 2 <= WS_R1 && WS_U + (size_t)MALL * FU * 2 <= WS_QR && WS_AB + (size_t)4 * MALL * 512 * 4 <= WS_QR, "d_ws map");
constexpr int CW_BAR = 4096;
constexpr int CW_Q = 8192;

constexpr int RING_BYTES = 131072;
constexpr int MISC_OFF = 144 * 1024 - 128;
constexpr int PTR_OFF = 144 * 1024 - 512;
constexpr int LDS_BYTES = 147456;

#define GAS __attribute__((address_space(1)))
#define LAS __attribute__((address_space(3)))
typedef unsigned short bf16;
typedef unsigned v4u __attribute__((ext_vector_type(4)));
typedef unsigned v2u __attribute__((ext_vector_type(2)));
typedef float f32x4 __attribute__((ext_vector_type(4)));
typedef short bf16x8 __attribute__((ext_vector_type(8)));
__device__ __forceinline__ unsigned f2bf(float f) { unsigned u = __builtin_bit_cast(unsigned, f); return (u + 0x7fffu + ((u >> 16) & 1u)) >> 16; }
typedef float f32x2_t __attribute__((ext_vector_type(2))); typedef __bf16 bf16x2_t __attribute__((ext_vector_type(2)));
__device__ __forceinline__ unsigned pk2(float lo, float hi) { f32x2_t v = {lo, hi}; bf16x2_t b = __builtin_convertvector(v, bf16x2_t); return __builtin_bit_cast(unsigned, b); }
__device__ __forceinline__ float bflo(unsigned w) { return __builtin_bit_cast(float, w << 16); }
__device__ __forceinline__ float bfhi(unsigned w) { return __builtin_bit_cast(float, w & 0xffff0000u); }
__device__ __forceinline__ float bf1(bf16 h) { return __builtin_bit_cast(float, (unsigned)h << 16); }
__device__ __forceinline__ void unpack8(v4u w, float (&x)[8]) { x[0] = bflo(w.x); x[1] = bfhi(w.x); x[2] = bflo(w.y); x[3] = bfhi(w.y); x[4] = bflo(w.z); x[5] = bfhi(w.z); x[6] = bflo(w.w); x[7] = bfhi(w.w); }
__device__ __forceinline__ v4u pack8(const float (&x)[8]) { v4u w; w.x = pk2(x[0], x[1]); w.y = pk2(x[2], x[3]); w.z = pk2(x[4], x[5]); w.w = pk2(x[6], x[7]); return w; }
__device__ __forceinline__ float sigm(float x) { return __builtin_amdgcn_rcpf(1.f + __expf(-x)); }
__device__ __forceinline__ float silu_f(float x) { return x * __builtin_amdgcn_rcpf(1.f + __expf(-x)); }
__device__ __forceinline__ float gelu_t(float x) { const float u = 0.7978845608028654f * (x + 0.044715f * x * x * x); return x * __builtin_amdgcn_rcpf(1.f + __expf(-2.f * u)); }
__device__ __forceinline__ float shx(float v, int mask, int lane) { return __builtin_bit_cast(float, __builtin_amdgcn_ds_bpermute((lane ^ mask) << 2, __builtin_bit_cast(int, v))); }
__device__ __forceinline__ unsigned shxu(unsigned v, int mask, int lane) { return (unsigned)__builtin_amdgcn_ds_bpermute((lane ^ mask) << 2, (int)v); }
__device__ __forceinline__ float wave_sum(float v, int lane) {
#pragma unroll
    for (int o = 1; o < 64; o <<= 1) v += shx(v, o, lane);
    return v;
}
#define LDS_WAIT() asm volatile("s_waitcnt lgkmcnt(0)" ::: "memory")
__device__ __forceinline__ f32x4 mfma16(bf16x8 a, bf16x8 b, f32x4 c) { return __builtin_amdgcn_mfma_f32_16x16x32_bf16(a, b, c, 0, 0, 0); }
__device__ __forceinline__ bf16x8 ldfrag(const bf16* p) { return *(const bf16x8*)p; }
#define XB_TMO      128
#define XB_XCNT(j)  (256  + 64 * (j))
#define XB_XSUB(j)  (1280 + 64 * (j))
#define XB_XGEN(j)  (2304 + 64 * (j))
#define XB_TOP      3328
#define XB_TOPGEN   3392
#define XCD_BAR_WORDS 3456
#define XB_SPIN_CAP (1u << 18)

__device__ __forceinline__ unsigned xb_ld(unsigned* p)              { return __hip_atomic_load(p, __ATOMIC_RELAXED, __HIP_MEMORY_SCOPE_AGENT); }
__device__ __forceinline__ unsigned xb_add(unsigned* p, unsigned v) { return __hip_atomic_fetch_add(p, v, __ATOMIC_RELAXED, __HIP_MEMORY_SCOPE_AGENT); }
__device__ __forceinline__ unsigned xb_xcc_id() { return (unsigned)__builtin_amdgcn_s_getreg((3 << 11) | 20) & 0xFu; }
#define XB_SPIN(cond, bar) do { unsigned _sp = 0; while (cond) { __builtin_amdgcn_s_sleep(1); \
    if ((++_sp & 255u) == 0u) { if (xb_ld(&(bar)[XB_TMO])) break; if (_sp > XB_SPIN_CAP) { atomicAdd(&(bar)[XB_TMO], 1u); break; } } } } while (0)

struct XcdBarrier {
    unsigned* bar; unsigned x;
    volatile LAS unsigned* st;
};

__device__ __forceinline__ XcdBarrier xcd_barrier_post(unsigned* bar, volatile LAS unsigned* st) {
    XcdBarrier b; b.bar = bar; b.x = xb_xcc_id(); b.st = st;
    if (threadIdx.x == 0) (void)xb_add(&bar[XB_XCNT(b.x)], 1u);
    return b;
}
__device__ __forceinline__ void xcd_barrier_complete(unsigned* bar, unsigned x, unsigned& nloc, unsigned& nx) {
    const unsigned G = gridDim.x * gridDim.y * gridDim.z;
    unsigned sum, cnt, mine, sp = 0u;
    for (;;) {
        sum = 0u; cnt = 0u; mine = 0u;
#pragma unroll
        for (unsigned j = 0; j < 16; ++j) { const unsigned c = xb_ld(&bar[XB_XCNT(j)]); sum += c; cnt += (c > 0u) ? 1u : 0u; mine = (j == x) ? c : mine; }
        if (sum == G) break;
        __builtin_amdgcn_s_sleep(1);
        if ((++sp & 255u) == 0u) { if (xb_ld(&bar[XB_TMO])) break; if (sp > XB_SPIN_CAP) { atomicAdd(&bar[XB_TMO], 1u); break; } }
    }
    nloc = mine > 0u ? mine : 1u; nx = cnt > 0u ? cnt : 1u;
}

__device__ __forceinline__ void xcd_barrier(const XcdBarrier& b, int tid  ) {
    asm volatile("s_waitcnt vmcnt(0)" ::: "memory");
    __syncthreads();
    if (tid == 0) {
        unsigned* bar = b.bar;
        __builtin_amdgcn_s_waitcnt(0);
        unsigned nloc = b.st[0], nx = b.st[1];
        if (nloc == 0u) { xcd_barrier_complete(bar, b.x, nloc, nx); b.st[0] = nloc; b.st[1] = nx; }
        const unsigned old = xb_add(&bar[XB_XSUB(b.x)], 1u);
        const unsigned gen = old / nloc;
        if (old + 1u == (gen + 1u) * nloc) {
            __builtin_amdgcn_fence(__ATOMIC_RELEASE, "agent");
            asm volatile("s_waitcnt vmcnt(0)" ::: "memory");
            const unsigned og = xb_add(&bar[XB_TOP], 1u);
            const unsigned tg = og / nx;
            if (og + 1u == (tg + 1u) * nx) xb_add(&bar[XB_TOPGEN], 1u);
            else XB_SPIN(xb_ld(&bar[XB_TOPGEN]) == tg, bar);
            __builtin_amdgcn_fence(__ATOMIC_ACQUIRE, "agent");
            xb_add(&bar[XB_XGEN(b.x)], 1u);
            asm volatile("s_waitcnt vmcnt(0)" ::: "memory");
        } else {
            XB_SPIN(xb_ld(&bar[XB_XGEN(b.x)]) == gen, bar);
            __builtin_amdgcn_fence(__ATOMIC_ACQUIRE, "agent");
            asm volatile("s_waitcnt vmcnt(0)" ::: "memory");
        }
    }
    __syncthreads();
}

struct Args { const float* in[25]; float* out; unsigned char* ws; int ph_lo, ph_hi; };
enum { I_X = 0, I_C, I_CTX, I_CCTX, I_WADA, I_BADA, I_NMG, I_NFG, I_WIN, I_LCW, I_LCB, I_LGW, I_LGB, I_LLAM, I_RPB, I_SLG, I_SLB, I_SW, I_SB, I_WOUT, I_FUP, I_FCW, I_FCB, I_FDN, I_FNG };
struct Frame {
    LAS unsigned char* lds;
    int tid, lane, wave, G, bid;
    unsigned char* ws; float* out;
    __device__ __forceinline__ const float* inp(int i) const { const unsigned long long v = *(const LAS unsigned long long*)(lds + PTR_OFF + 8 * i);
        return (const float*)(const GAS float*)(((unsigned long long)(unsigned)__builtin_amdgcn_readfirstlane((int)(v >> 32)) << 32) | (unsigned long long)(unsigned)__builtin_amdgcn_readfirstlane((int)(unsigned)v)); }
    __device__ __forceinline__ float* MOD() const { return (float*)(ws + WS_MOD); }
    __device__ __forceinline__ bf16* GWT() const { return (bf16*)(ws + WS_GWT); }
    __device__ __forceinline__ bf16* SWB() const { return (bf16*)(ws + WS_SWB); }
    __device__ __forceinline__ float* AGG() const { return (float*)(ws + WS_AGG); }
    __device__ __forceinline__ float* AGT() const { return (float*)(ws + WS_AGT); }
    __device__ __forceinline__ float* ROPE() const { return (float*)(ws + WS_ROPE); }
    __device__ __forceinline__ float* C8() const { return (float*)(ws + WS_ROPE + 16384); }
    __device__ __forceinline__ bf16* X() const { return (bf16*)(ws + WS_X); }
    __device__ __forceinline__ bf16* HX() const { return (bf16*)(ws + WS_HX); }
    __device__ __forceinline__ bf16* ACT() const { return (bf16*)(ws + WS_ACT); }
    __device__ __forceinline__ bf16* Z() const { return (bf16*)(ws + WS_Z); }
    __device__ __forceinline__ bf16* MIX() const { return (bf16*)(ws + WS_MIX); }
    __device__ __forceinline__ unsigned* AB2() const { return (unsigned*)(ws + WS_AB); }
    __device__ __forceinline__ bf16* U() const { return (bf16*)(ws + WS_U); }
    __device__ __forceinline__ bf16* QR() const { return (bf16*)(ws + WS_QR); }
    __device__ __forceinline__ bf16* KR() const { return (bf16*)(ws + WS_KR); }
    __device__ __forceinline__ bf16* VT() const { return (bf16*)(ws + WS_VT); }
    __device__ __forceinline__ bf16* KC() const { return (bf16*)(ws + WS_KC); }
    __device__ __forceinline__ bf16* VTC() const { return (bf16*)(ws + WS_VTC); }
};

__device__ __forceinline__ void p0_transpose_item(const float* W, int K, int N, bf16* WT, LAS float* scr, int item, int lane) {
    const int nblk = N / 32, kb = item / nblk, nb = item % nblk, k0 = 64 * kb, n0 = 32 * nb;
#pragma unroll 8
    for (int i = 0; i < 32; ++i) { const int kk = 2 * i + (lane >> 5); scr[kk * 33 + (lane & 31)] = W[(size_t)(k0 + kk) * N + n0 + (lane & 31)]; }
    LDS_WAIT(); asm volatile("" ::: "memory");
    const int c = lane & 7;
#pragma unroll
    for (int j = 0; j < 4; ++j) { const int n = (lane >> 3) + 8 * j; const LAS float* s = scr + (8 * c) * 33 + n;
        v4u o; o.x = pk2(s[0 * 33], s[1 * 33]); o.y = pk2(s[2 * 33], s[3 * 33]); o.z = pk2(s[4 * 33], s[5 * 33]); o.w = pk2(s[6 * 33], s[7 * 33]);
        *(v4u*)(WT + (size_t)(n0 + n) * K + k0 + 8 * c) = o; }
    LDS_WAIT(); asm volatile("" ::: "memory");
}
__device__ __forceinline__ void p0_adaln_unit(Frame& F, int L, int cb) {
    LAS float* sc = (LAS float*)F.lds;
    const float* c = F.inp(I_C); const float* cc = F.inp(I_CCTX);
    for (int i = F.tid; i < 9 * 2048; i += NTHREADS) { const int v = i >> 11, k = i & 2047; const float x = v < 8 ? c[v * 2048 + k] : cc[k]; sc[k * 12 + v] = silu_f(x); }
    __syncthreads();
    const float* W = F.inp(I_WADA) + (size_t)L * DM * MODW + cb * 256 + 4 * F.lane;
    f32x4 acc[9];
#pragma unroll
    for (int v = 0; v < 9; ++v) acc[v] = (f32x4){0.f, 0.f, 0.f, 0.f};
    const int kbeg = F.wave * 256;
    for (int k = kbeg; k < kbeg + 256; k += 8) {
        f32x4 w[8];
#pragma unroll
        for (int q = 0; q < 8; ++q) w[q] = *(const f32x4*)(W + (size_t)(k + q) * MODW);
#pragma unroll
        for (int q = 0; q < 8; ++q) {
            const f32x4 s0 = *(const LAS f32x4*)(sc + (k + q) * 12), s1 = *(const LAS f32x4*)(sc + (k + q) * 12 + 4); const float s8 = sc[(k + q) * 12 + 8];
            acc[0] += w[q] * s0.x; acc[1] += w[q] * s0.y; acc[2] += w[q] * s0.z; acc[3] += w[q] * s0.w;
            acc[4] += w[q] * s1.x; acc[5] += w[q] * s1.y; acc[6] += w[q] * s1.z; acc[7] += w[q] * s1.w; acc[8] += w[q] * s8;
        }
    }
    __syncthreads();
    LAS float* red = (LAS float*)F.lds;
#pragma unroll
    for (int v = 0; v < 9; ++v) *(LAS f32x4*)(red + (F.wave * 9 + v) * 256 + 4 * F.lane) = acc[v];
    __syncthreads();
    const float* bias = F.inp(I_BADA) + (size_t)L * MODW + cb * 256;
    for (int o = F.tid; o < 9 * 256; o += NTHREADS) { const int v = o >> 8, col = o & 255; float s = bias[col];
#pragma unroll
        for (int w = 0; w < 8; ++w) s += red[(w * 9 + v) * 256 + col];
        F.MOD()[((size_t)L * 9 + v) * MODW + cb * 256 + col] = s; }
    __syncthreads();
}
__device__ __forceinline__ void convert_layer(Frame& F, int L, int cu0, int ncu) {
    if (F.bid < cu0 || F.bid >= cu0 + ncu) return;
    LAS float* scr = (LAS float*)(F.lds + F.wave * 16384);
    const int gw = (F.bid - cu0) * NWAVES + F.wave, NGW = ncu * NWAVES;
    bf16* wt = (bf16*)(F.ws + WS_WT + (size_t)L * WT_LAYER);
    const float* w_in = F.inp(I_WIN) + (size_t)L * DM * PW; const float* w_out = F.inp(I_WOUT) + (size_t)L * DM * DM;
    const float* w_up = F.inp(I_FUP) + (size_t)L * DM * FU; const float* w_dn = F.inp(I_FDN) + (size_t)L * FH * DM;
    for (int it = gw; it < (DM / 64) * (PW / 32); it += NGW) p0_transpose_item(w_in, DM, PW, (bf16*)((char*)wt + WT_IN), scr, it, F.lane);
    for (int it = gw; it < (DM / 64) * (DM / 32); it += NGW) p0_transpose_item(w_out, DM, DM, (bf16*)((char*)wt + WT_OUT), scr, it, F.lane);
    for (int it = gw; it < (DM / 64) * (FU / 32); it += NGW) p0_transpose_item(w_up, DM, FU, (bf16*)((char*)wt + WT_UP), scr, it, F.lane);
    for (int it = gw; it < (FH / 64) * (DM / 32); it += NGW) p0_transpose_item(w_dn, FH, DM, (bf16*)((char*)wt + WT_DN), scr, it, F.lane);
}
__device__ __forceinline__ void p0_prologue(Frame& F) {
    for (int u = F.bid; u < DEPTH * 48; u += F.G) p0_adaln_unit(F, u / 48, u % 48);
    { const int gi = F.bid * NTHREADS + F.tid;
      if (gi < 1024) { const int pos = gi >> 4, f = gi & 15; double inv = 1.0; for (int i = 0; i < f; ++i) inv *= 0.5623413251903491;
          const float ang = (float)pos * (float)inv; double y = (double)ang; const double twopi = 6.283185307179586476925;
          const double kk = __builtin_rint(y / twopi); y -= kk * twopi; const double y2 = y * y;
          double cs = 1.0, sn = y, tc = 1.0, ts = y;
          for (int n = 1; n <= 16; ++n) { tc *= -y2 / (double)((2 * n - 1) * (2 * n)); ts *= -y2 / (double)((2 * n) * (2 * n + 1)); cs += tc; sn += ts; }
          F.ROPE()[gi * 2] = (float)cs; F.ROPE()[gi * 2 + 1] = (float)sn; } }
    { const int gi = F.bid * NTHREADS + F.tid, GN = F.G * NTHREADS; const float* gw = F.inp(I_LGW); const float* sw = F.inp(I_SW);
      for (int e = gi; e < DEPTH * 32 * 4096; e += GN) { const int m = e >> 12, o = (e >> 6) & 63, i = e & 63; F.GWT()[e] = (bf16)f2bf(gw[(size_t)m * 4096 + i * 64 + o]); }
      for (int e = gi; e < DEPTH * 8 * 16384; e += GN) F.SWB()[e] = (bf16)f2bf(sw[e]);
      const float* lam = F.inp(I_LLAM); for (int e = gi; e < DEPTH * 1024; e += GN) F.C8()[e] = -8.0f * log1pf(__expf(-lam[e])); }
    for (int L = 0; L < DEPTH; ++L) convert_layer(F, L, 0, F.G);
}

__device__ __forceinline__ void norm_rows(Frame& F, const float* src32, const bf16* src16, int row0, int nrows, const float* g, const float* sh, const float* sc) {
    f32x4 A[8], B[8];
#pragma unroll
    for (int j = 0; j < 8; ++j) { const int col = 4 * F.lane + 256 * j; const f32x4 gg = *(const f32x4*)(g + col), s = *(const f32x4*)(sc + col); A[j] = gg * (s + 1.0f); B[j] = *(const f32x4*)(sh + col); }
    for (int r = 0; r < nrows; ++r) {
        f32x4 v[8]; float s = 0.f;
        if (src32) { const f32x4* xr = (const f32x4*)(src32 + (size_t)(row0 + r) * DM) + F.lane;
#pragma unroll
            for (int j = 0; j < 8; ++j) v[j] = xr[64 * j]; }
        else { const v2u* xr = (const v2u*)(src16 + (size_t)(row0 + r) * DM) + F.lane;
#pragma unroll
            for (int j = 0; j < 8; ++j) { const v2u d = xr[64 * j]; v[j] = (f32x4){bflo(d.x), bfhi(d.x), bflo(d.y), bfhi(d.y)}; } }
#pragma unroll
        for (int j = 0; j < 8; ++j) s += (v[j].x * v[j].x + v[j].y * v[j].y) + (v[j].z * v[j].z + v[j].w * v[j].w);
        const float rstd = __builtin_amdgcn_rsqf(wave_sum(s, F.lane) * (1.0f / DM) + NORM_EPS);
        v2u* o = (v2u*)(F.HX() + (size_t)(row0 + r) * DM) + F.lane;
#pragma unroll
        for (int j = 0; j < 8; ++j) { const f32x4 y = v[j] * rstd * A[j] + B[j]; v2u w; w.x = pk2(y.x, y.y); w.y = pk2(y.z, y.w); o[64 * j] = w; }
    }
}
__device__ __forceinline__ void norm_range(Frame& F, int L, int which  , int r0, int r1) {
    if (r1 <= r0) return;
    const float* g = (which ? F.inp(I_NFG) : F.inp(I_NMG)) + (size_t)L * DM;
    const float* mod = F.MOD() + (size_t)L * 9 * MODW + (which ? 3 * DM : 0);
    const bool first = (L == 0 && which == 0);
    const int n = r1 - r0, per = (n + NWAVES - 1) / NWAVES; int a = r0 + F.wave * per, e = a + per < r1 ? a + per : r1;
    while (a < e) {
        const int v = a < MLAT ? (a >> 11) : 8; const int vend = a < MLAT ? ((a >> 11) + 1) << 11 : MALL; const int stop = e < vend ? e : vend;
        const float* m = mod + (size_t)v * MODW;
        const float* src32 = first ? (a < MLAT ? F.inp(I_X) : F.inp(I_CTX) - (size_t)MLAT * DM) : nullptr;
        norm_rows(F, src32, F.X(), a, stop - a, g, m, m + DM);
        a = stop;
    }
}
__device__ __forceinline__ void share(int rb, int re, int idx, int n, int& r0, int& r1) { const int per = (re - rb + n - 1) / n; r0 = rb + idx * per; r1 = r0 + per; if (r0 > re) r0 = re; if (r1 > re) r1 = re; }
__device__ __forceinline__ void final_norm_phase(Frame& F) {
    const int gw = F.bid * NWAVES + F.wave, NGW = F.G * NWAVES; const float* g = F.inp(I_FNG);
    f32x4 A[8];
#pragma unroll
    for (int j = 0; j < 8; ++j) A[j] = *(const f32x4*)(g + 4 * F.lane + 256 * j);
    for (int row = gw; row < MLAT; row += NGW) {
        const v2u* xr = (const v2u*)(F.X() + (size_t)row * DM) + F.lane; f32x4 v[8]; float s = 0.f;
#pragma unroll
        for (int j = 0; j < 8; ++j) { const v2u d = xr[64 * j]; v[j] = (f32x4){bflo(d.x), bfhi(d.x), bflo(d.y), bfhi(d.y)}; s += (v[j].x * v[j].x + v[j].y * v[j].y) + (v[j].z * v[j].z + v[j].w * v[j].w); }
        const float rstd = __builtin_amdgcn_rsqf(wave_sum(s, F.lane) * (1.0f / DM) + NORM_EPS);
        f32x4* o = (f32x4*)(F.out + (size_t)row * DM) + F.lane;
#pragma unroll
        for (int j = 0; j < 8; ++j) o[64 * j] = v[j] * rstd * A[j];
    }
}

__device__ __forceinline__ void convgate_phase(Frame& F, int L, int rbeg, int rend, int cu0, int ncu) {
    if (F.bid < cu0 || F.bid >= cu0 + ncu || rend <= rbeg) return;
    const int NRANGE = (ncu * NWAVES * 4) / 43;
    const int rlen = (rend - rbeg + NRANGE - 1) / NRANGE;
    const float* cw = F.inp(I_FCW) + (size_t)L * 3 * FU; const float* cbv = F.inp(I_FCB) + (size_t)L * FU;
    const bf16* U = F.U(); const v4u zero = (v4u){0u, 0u, 0u, 0u};
    for (int q = ((F.bid - cu0) * NWAVES + F.wave) * 4 + (F.lane >> 4); q < 43 * NRANGE; q += ncu * NWAVES * 4) {
        const int cb = q % 43, rg = q / 43, cl = F.lane & 15, j0 = cb * 128 + cl * 8;
        const int r_lo = rbeg + rg * rlen, r_hi = (r_lo + rlen < rend) ? r_lo + rlen : rend;
        float wa[3][8], wg[3][8], ba[8], bg[8];
#pragma unroll
        for (int k = 0; k < 3; ++k)
#pragma unroll
            for (int e = 0; e < 8; ++e) { wa[k][e] = cw[(size_t)k * FU + j0 + e]; wg[k][e] = cw[(size_t)k * FU + FH + j0 + e]; }
#pragma unroll
        for (int e = 0; e < 8; ++e) { ba[e] = cbv[j0 + e]; bg[e] = cbv[FH + j0 + e]; }
        v4u pA, pG, cA[4], cG[4], nA[4], nG[4];
#define CG_LD(r_, a_, g_) do { const int r__ = (r_); if (r__ >= rbeg && r__ < rend) { a_ = *(const v4u*)(U + (size_t)r__ * FU + j0); g_ = *(const v4u*)(U + (size_t)r__ * FU + FH + j0); } else { a_ = zero; g_ = zero; } } while (0)
        CG_LD(r_lo - 1, pA, pG);
#pragma unroll
        for (int i = 0; i < 4; ++i) CG_LD(r_lo + i, cA[i], cG[i]);
        for (int r = r_lo; r < r_hi; r += 4) {
#pragma unroll
            for (int i = 0; i < 4; ++i) CG_LD(r + 4 + i, nA[i], nG[i]);
#pragma unroll
            for (int i = 0; i < 4; ++i) {
                const int rr = r + i;
                if (rr < r_hi) {
                    const bool first = rr < MLAT ? (rr & 2047) == 0 : (rr & 255) == 0, last = rr < MLAT ? (rr & 2047) == 2047 : (rr & 255) == 255;
                    v4u la = (i == 0) ? pA : cA[(i + 3) & 3], lg = (i == 0) ? pG : cG[(i + 3) & 3], ra = (i == 3) ? nA[0] : cA[(i + 1) & 3], rgv = (i == 3) ? nG[0] : cG[(i + 1) & 3];
                    if (first) { la = zero; lg = zero; }
                    if (last) { ra = zero; rgv = zero; }
                    float xp[8], xc[8], xn[8], yp[8], yc[8], yn[8], o[8];
                    unpack8(la, xp); unpack8(cA[i], xc); unpack8(ra, xn); unpack8(lg, yp); unpack8(cG[i], yc); unpack8(rgv, yn);
#pragma unroll
                    for (int e = 0; e < 8; ++e) { const float a = ba[e] + wa[0][e] * xp[e] + wa[1][e] * xc[e] + wa[2][e] * xn[e]; const float g = bg[e] + wg[0][e] * yp[e] + wg[1][e] * yc[e] + wg[2][e] * yn[e]; o[e] = silu_f(g) * a; }
                    *(v4u*)(F.ACT() + (size_t)rr * FH + j0) = pack8(o);
                }
            }
            pA = cA[3]; pG = cG[3];
#pragma unroll
            for (int i = 0; i < 4; ++i) { cA[i] = nA[i]; cG[i] = nG[i]; }
        }
#undef CG_LD
    }
}

constexpr float AT_SC = 0.125f * 1.4426950408889634f;
__device__ __forceinline__ v4u rope_chunk(v4u own, int lane, bool is_x2, const float* cs  , float scale) {
    v4u par; par.x = shxu(own.x, 2, lane); par.y = shxu(own.y, 2, lane); par.z = shxu(own.z, 2, lane); par.w = shxu(own.w, 2, lane);
    float x[8], p[8], o[8]; unpack8(own, x); unpack8(par, p);
#pragma unroll
    for (int e = 0; e < 8; ++e) { const float c = cs[2 * e], s = cs[2 * e + 1]; o[e] = (is_x2 ? (x[e] * c + p[e] * s) : (x[e] * c - p[e] * s)) * scale; }
    return pack8(o);
}
__device__ __forceinline__ void prep_unit(Frame& F, bool ctx, int b, int h, int tt) {
    const int lane = F.lane, c = lane & 7;
    const int bh = b * NH + h;
    const size_t zrow0 = ctx ? (size_t)(MLAT + b * CTXL + 64 * tt) : (size_t)(b * SEQ + 64 * tt);
    const int half = c >> 2; const bool is_x2 = (c >> 1) & 1; const int f0 = 8 * (c & 1);
    struct PrepOps { v4u kq; f32x4 t4[4]; };
    PrepOps po[2];
#define PREP_LOAD(i_, o_) do { const int tl_ = 8 * (i_) + (lane >> 3); const bf16* zr_ = F.Z() + (zrow0 + tl_) * PW + 64 * h + 8 * c; \
        (o_).kq = *(const v4u*)(zr_ + ZC_K); \
        if (!ctx) { const int pos_ = half ? tl_ : tt; \
            _Pragma("unroll") for (int e = 0; e < 4; ++e) (o_).t4[e] = *(const f32x4*)(F.ROPE() + (pos_ * 16 + f0) * 2 + 4 * e); } } while (0)
    PREP_LOAD(0, po[0]);
#pragma unroll
    for (int i = 0; i < 8; ++i) {
        if (i + 1 < 8) PREP_LOAD(i + 1, po[(i + 1) & 1]);
        __builtin_amdgcn_sched_barrier(0);
        const PrepOps& o = po[i & 1];
        const int tl = 8 * i + (lane >> 3);
        if (!ctx) {
            float cs[16];
#pragma unroll
            for (int e = 0; e < 4; ++e) { cs[4 * e] = o.t4[e].x; cs[4 * e + 1] = o.t4[e].y; cs[4 * e + 2] = o.t4[e].z; cs[4 * e + 3] = o.t4[e].w; }
            const size_t off = ((size_t)bh * SEQ + 64 * tt + tl) * 64 + 8 * c;
            *(v4u*)(F.KR() + off) = rope_chunk(o.kq, lane, is_x2, cs, AT_SC);
        } else {
            float kx[8]; unpack8(o.kq, kx);
#pragma unroll
            for (int e = 0; e < 8; ++e) kx[e] *= AT_SC;
            *(v4u*)(F.KC() + ((size_t)bh * CTXL + 64 * tt + tl) * 64 + 8 * c) = pack8(kx);
        }
        __builtin_amdgcn_sched_barrier(0);
    }
#undef PREP_LOAD
}

constexpr int XC_ROW = 68;
__device__ __forceinline__ float one_minus_exp_neg(float x) {
    const float p = x * (1.0f + x * (-0.5f + x * (0.16666667f + x * (-0.041666668f + x * (0.0083333338f + x * -0.0013888889f)))));
    return x < 0.125f ? p : 1.0f - __expf(-x);
}
__device__ __forceinline__ void lru_ab_unit(Frame& F, int L, int u) {
    const int mc = u >> 2, q4 = u & 3;
    const int lane = F.lane, tt = F.wave >> 1, g = 2 * q4 + (F.wave & 1), tok = lane & 15, kg = lane >> 4;
    const int R0 = 64 * mc, R = R0 + 16 * tt + tok;
    const int seq_lo = mc < 256 ? (mc >> 5) * SEQ : MLAT + ((mc - 256) >> 2) * CTXL, seq_hi = seq_lo + (mc < 256 ? SEQ : CTXL);
    LAS float* xcs = (LAS float*)(F.lds + F.wave * (16 * XC_ROW * 4));
    const float* gb = F.inp(I_LGB) + (size_t)L * 4 * 512; const float* c8t = F.C8() + (size_t)L * 2 * 512;
    struct GateOps { bf16x8 wr0, wr1, wi0, wi1; f32x4 gbr, gbi, c8; };
    GateOps ops[2];
#define LRU_LOAD_OPS(it_, o_) do { const int d_ = (it_) >> 2, ot_ = (it_) & 3; \
        const bf16* wp_ = F.GWT() + ((((size_t)L * 2 + d_) * 2) * 8 + g) * 4096 + (16 * ot_ + tok) * 64 + 8 * kg;     \
        (o_).wr0 = ldfrag(wp_); (o_).wr1 = ldfrag(wp_ + 32); (o_).wi0 = ldfrag(wp_ + 8 * 4096); (o_).wi1 = ldfrag(wp_ + 8 * 4096 + 32); \
        const int ch_ = 64 * g + 16 * ot_ + 4 * kg; \
        (o_).gbr = *(const f32x4*)(gb + (d_ * 2 + 0) * 512 + ch_); (o_).gbi = *(const f32x4*)(gb + (d_ * 2 + 1) * 512 + ch_); (o_).c8 = *(const f32x4*)(c8t + d_ * 512 + ch_); } while (0)
    {
        const float* cw = F.inp(I_LCW) + (size_t)L * 4 * 512 + 64 * g + 8 * kg; const float* cb = F.inp(I_LCB) + (size_t)L * 512 + 64 * g + 8 * kg;
        v4u z[2][4]; f32x4 w0[2][4], w1[2][4], b0[2], b1[2];
#pragma unroll
        for (int ks = 0; ks < 2; ++ks) {
#pragma unroll
            for (int k = 0; k < 4; ++k) { const int Rt = R + k - 2; z[ks][k] = (Rt >= seq_lo && Rt < seq_hi) ? *(const v4u*)(F.Z() + (size_t)Rt * PW + ZC_AX + 64 * g + 32 * ks + 8 * kg) : (v4u){0u, 0u, 0u, 0u};
                w0[ks][k] = *(const f32x4*)(cw + k * 512 + 32 * ks); w1[ks][k] = *(const f32x4*)(cw + k * 512 + 32 * ks + 4); }
            b0[ks] = *(const f32x4*)(cb + 32 * ks); b1[ks] = *(const f32x4*)(cb + 32 * ks + 4);
        }
        LRU_LOAD_OPS(0, ops[0]);
        __builtin_amdgcn_sched_barrier(0);
#pragma unroll
        for (int ks = 0; ks < 2; ++ks) {
            float a[8] = {b0[ks].x, b0[ks].y, b0[ks].z, b0[ks].w, b1[ks].x, b1[ks].y, b1[ks].z, b1[ks].w};
#pragma unroll
            for (int k = 0; k < 4; ++k) { float x[8]; unpack8(z[ks][k], x); const f32x4 u0 = w0[ks][k], u1 = w1[ks][k];
                a[0] += u0.x * x[0]; a[1] += u0.y * x[1]; a[2] += u0.z * x[2]; a[3] += u0.w * x[3]; a[4] += u1.x * x[4]; a[5] += u1.y * x[5]; a[6] += u1.z * x[6]; a[7] += u1.w * x[7]; }
            LAS f32x4* dst = (LAS f32x4*)(xcs + tok * XC_ROW + 32 * ks + 8 * kg);
            dst[0] = (f32x4){a[0], a[1], a[2], a[3]}; dst[1] = (f32x4){a[4], a[5], a[6], a[7]};
        }
    }
    LDS_WAIT(); asm volatile("" ::: "memory");
    bf16x8 xb[2];
    { const LAS float* xr = xcs + tok * XC_ROW;
#pragma unroll
      for (int ks = 0; ks < 2; ++ks) { const f32x4 x0 = *(const LAS f32x4*)(xr + 32 * ks + 8 * kg), x1 = *(const LAS f32x4*)(xr + 32 * ks + 8 * kg + 4);
          v4u pw; pw.x = pk2(x0.x, x0.y); pw.y = pk2(x0.z, x0.w); pw.z = pk2(x1.x, x1.y); pw.w = pk2(x1.z, x1.w); xb[ks] = __builtin_bit_cast(bf16x8, pw); } }
#pragma unroll
    for (int it = 0; it < 8; ++it) {
        if (it + 1 < 8) LRU_LOAD_OPS(it + 1, ops[(it + 1) & 1]);
        __builtin_amdgcn_sched_barrier(0);
        const GateOps& o = ops[it & 1]; const int d = it >> 2, ot = it & 3, ch = 64 * g + 16 * ot + 4 * kg;
        const f32x4 xd = *(const LAS f32x4*)(xcs + tok * XC_ROW + 16 * ot + 4 * kg);
        f32x4 ar = o.gbr, ai = o.gbi;
        ar = mfma16(o.wr0, xb[0], ar); ar = mfma16(o.wr1, xb[1], ar);
        ai = mfma16(o.wi0, xb[0], ai); ai = mfma16(o.wi1, xb[1], ai);
        v4u ov;
#pragma unroll
        for (int e = 0; e < 4; ++e) { const float r = sigm(ar[e]), ig = sigm(ai[e]);
            const float oma = 1.0f - __expf(o.c8[e] * r);
            const float bb = __builtin_amdgcn_sqrtf(oma * (2.0f - oma)) * (ig * xd[e]);
            ov[e] = pk2(oma, bb); }
        *(v4u*)(F.AB2() + (size_t)d * MALL * 512 + (size_t)R * 512 + ch) = ov;
        __builtin_amdgcn_sched_barrier(0);
    }
#undef LRU_LOAD_OPS
    __syncthreads();
    {
        const int cl = F.tid & 127, seg = F.tid >> 7, ch = 128 * q4 + cl;
        const unsigned* p0 = F.AB2() + (size_t)(R0 + 16 * seg) * 512 + ch; const unsigned* p1 = p0 + (size_t)MALL * 512;
        unsigned w0[16], w1[16];
#pragma unroll
        for (int t = 0; t < 16; ++t) { w0[t] = p0[t * 512]; w1[t] = p1[t * 512]; }
        float Af = 1.f, Bf = 0.f, Ab = 1.f, Bb = 0.f;
#pragma unroll
        for (int t = 0; t < 16; ++t) { const float a = 1.0f - bflo(w0[t]), b = bfhi(w0[t]); Bf = a * Bf + b; Af *= a; }
#pragma unroll
        for (int t = 15; t >= 0; --t) { const float a = 1.0f - bflo(w1[t]), b = bfhi(w1[t]); Bb = a * Bb + b; Ab *= a; }
        float* at = F.AGT() + ((size_t)(4 * mc + seg) * 2) * 512 + ch;
        at[0] = Af; at[512] = Bf; at[(size_t)4 * NCHUNK * 1024] = Ab; at[(size_t)4 * NCHUNK * 1024 + 512] = Bb;
        LAS f32x4* ex = (LAS f32x4*)(F.lds + 40960);
        ex[seg * 128 + cl] = (f32x4){Af, Bf, Ab, Bb};
        __syncthreads();
        if (seg == 0) {
            f32x4 e0 = ex[cl], e1 = ex[128 + cl], e2 = ex[256 + cl], e3 = ex[384 + cl];
            float A = e0.x, B = e0.y; B = e1.x * B + e1.y; A *= e1.x; B = e2.x * B + e2.y; A *= e2.x; B = e3.x * B + e3.y; A *= e3.x;
            float C = e3.z, D = e3.w; D = e2.z * D + e2.w; C *= e2.z; D = e1.z * D + e1.w; C *= e1.z; D = e0.z * D + e0.w; C *= e0.z;
            float* ag = F.AGG() + ((size_t)mc * 2) * 512 + ch;
            ag[0] = A; ag[512] = B; ag[(size_t)NCHUNK * 1024] = C; ag[(size_t)NCHUNK * 1024 + 512] = D;
        }
    }
    __syncthreads();
}
__device__ __forceinline__ void lru_d_unit(Frame& F, int u) {
    const int mc = u >> 2, q4 = u & 3;
    const int cl = F.tid & 127, seg = F.tid >> 7, ch = 128 * q4 + cl, R0 = 64 * mc + 16 * seg;
    const unsigned* p0 = F.AB2() + (size_t)R0 * 512 + ch; const unsigned* p1 = p0 + (size_t)MALL * 512;
    const bf16* yp = F.Z() + (size_t)R0 * PW + ZC_AY + ch; bf16* op = F.MIX() + (size_t)R0 * DM + ch;
    unsigned w0[16], w1[16]; bf16 yv[16];
#pragma unroll
    for (int t = 0; t < 16; ++t) { w0[t] = p0[t * 512]; w1[t] = p1[t * 512]; yv[t] = yp[(size_t)t * PW]; }
    float taf[4][2], tab[4][2];
    { const float* atf = F.AGT() + ch; const float* atb = F.AGT() + (size_t)4 * NCHUNK * 1024 + ch;
#pragma unroll
      for (int sgi = 0; sgi < 4; ++sgi) { const float* a = atf + (size_t)(4 * mc + sgi) * 1024; const float* c = atb + (size_t)(4 * mc + sgi) * 1024; taf[sgi][0] = a[0]; taf[sgi][1] = a[512]; tab[sgi][0] = c[0]; tab[sgi][1] = c[512]; } }
    __builtin_amdgcn_sched_barrier(0);
    const float* agf = F.AGG() + ch; const float* agb = F.AGG() + (size_t)NCHUNK * 1024 + ch;
    float hf = 0.f, hb = 0.f;
    const bool lat = mc < 256; const int b = lat ? (mc >> 5) : ((mc - 256) >> 2), lc = lat ? (mc & 31) : ((mc - 256) & 3);
    const int cbase = 256 + 4 * b, lbase = 32 * b;
    const int nfc = lat ? 4 : lc, nfl = lat ? lc : 0, nbc = lat ? 4 : 3 - lc, nbl = lat ? 31 - lc : 0;
#pragma unroll 4
    for (int p = 0; p < 4; ++p) {
        if (p < nfc) { const float* a = agf + (size_t)(cbase + p) * 1024; hf = a[0] * hf + a[512]; }
        if (p < nbc) { const float* a = agb + (size_t)(cbase + 3 - p) * 1024; hb = a[0] * hb + a[512]; }
    }
    { const int nmax = nfl > nbl ? nfl : nbl;
#pragma unroll 8
      for (int p = 0; p < nmax; ++p) {
          const int pf = p < nfl ? p : 0, pb = p < nbl ? p : 0;
          const float* a = agf + (size_t)(lbase + pf) * 1024; const float* c = agb + (size_t)(lbase + 31 - pb) * 1024;
          const float a0 = a[0], a1 = a[512], c0 = c[0], c1 = c[512];
          hf = p < nfl ? a0 * hf + a1 : hf; hb = p < nbl ? c0 * hb + c1 : hb; } }
#pragma unroll
    for (int sgi = 0; sgi < 3; ++sgi) hf = sgi < seg ? taf[sgi][0] * hf + taf[sgi][1] : hf;
#pragma unroll
    for (int sgi = 3; sgi > 0; --sgi) hb = sgi > seg ? tab[sgi][0] * hb + tab[sgi][1] : hb;
    float hfv[16];
#pragma unroll
    for (int t = 0; t < 16; ++t) { hf = (1.0f - bflo(w0[t])) * hf + bfhi(w0[t]); hfv[t] = hf; }
#pragma unroll
    for (int t = 15; t >= 0; --t) { hb = (1.0f - bflo(w1[t])) * hb + bfhi(w1[t]); op[(size_t)t * DM] = (bf16)f2bf((hfv[t] + hb) * gelu_t(bf1(yv[t]))); }
}

constexpr int AT_CTX_OFF = 61440, AT_RPB_OFF = AT_CTX_OFF + 65536;
constexpr int AT_ROPE_OFF = AT_RPB_OFF + 2560;
static_assert(AT_ROPE_OFF % 16 == 0 && AT_ROPE_OFF + 8192 <= PTR_OFF, "attention LDS map");
constexpr int AT_BX_OFF = AT_CTX_OFF + 32768;
struct AtUnit { int bh, r0, c0, qrow0; };
template <bool WIN> __device__ __forceinline__ void at_geom(const AtUnit& u, int& rs0, int& nlr, int& kc0) {
    rs0 = u.r0 - 4 < 0 ? 0 : (u.r0 - 4 > 24 ? 24 : u.r0 - 4); const int rl = u.r0 + 7 - 4 > 24 ? 24 : u.r0 + 7 - 4; nlr = WIN ? rl + 8 - rs0 : 0;
    kc0 = u.c0 - 8 < 0 ? 0 : (u.c0 - 8 > 32 ? 32 : u.c0 - 8);
}
template <bool WIN, int PART = 0  > __device__ __forceinline__ void at_load_k(Frame& F, int tid, const AtUnit& u, v4u (&reg)[12], float& rpbv, int L) {
    int rs0, nlr, kc0; at_geom<WIN>(u, rs0, nlr, kc0);
    if constexpr (WIN && PART != 2) rpbv = F.inp(I_RPB)[((size_t)L * NH + (u.bh & 15)) * 465 + (tid < 465 ? tid : 464)];
    if constexpr (WIN && PART != 2) {
#pragma unroll
        for (int jj = 0; jj < 8; ++jj) { const int n = tid + 512 * jj; const int i = n & 15, c = (n >> 4) & 7, tile = n >> 7, T = tile & 1; int lr = tile >> 1; lr = lr < nlr ? lr : nlr - 1;
            reg[jj] = *(const v4u*)(F.KR() + ((size_t)u.bh * SEQ + (rs0 + lr) * 64 + kc0 + 8 * (i >> 2) + 4 * T + (i & 3)) * 64 + 8 * c); }
    }
    if constexpr (PART != 1)
#pragma unroll
    for (int jj = 0; jj < 4; ++jj) { const int n = tid + 512 * jj, i = n & 15, c = (n >> 4) & 7, tile = n >> 7;
        reg[8 + jj] = *(const v4u*)(F.KC() + ((size_t)u.bh * CTXL + 32 * (tile >> 1) + 8 * (i >> 2) + 4 * (tile & 1) + (i & 3)) * 64 + 8 * c); }
}
template <bool WIN> __device__ __forceinline__ void at_load_v(Frame& F, int tid, const AtUnit& u, v4u (&reg)[12]) {
    int rs0, nlr, kc0; at_geom<WIN>(u, rs0, nlr, kc0);
    const int h = u.bh & 15, b = u.bh >> 4, c = tid & 7, col = (tid >> 3) & 31, lr0 = tid >> 8;
    if constexpr (WIN) {
        const bf16* base = F.Z() + ((size_t)b * SEQ + rs0 * 64 + kc0) * PW + ZC_V + 64 * h;
        const unsigned lane_off = (unsigned)(col * PW + 8 * c);
#pragma unroll
        for (int jj = 0; jj < 8; ++jj) { int lr = lr0 + 2 * jj; lr = lr < nlr ? lr : nlr - 1;
            reg[jj] = *(const v4u*)(base + (lane_off + (unsigned)lr * (unsigned)(64 * PW))); }
    }
    { const bf16* base = F.Z() + ((size_t)MLAT + b * CTXL) * PW + ZC_V + 64 * h;
#pragma unroll
      for (int jj = 0; jj < 4; ++jj) reg[8 + jj] = *(const v4u*)(base + ((unsigned)((tid >> 3) + 64 * jj) * (unsigned)PW + 8 * c)); }
}
__device__ __forceinline__ int at_vswz(int tid) { const int r = (tid >> 3) & 31; return (((r >> 1) & 1) | (((r >> 3) & 1) << 1)) << 5; }
template <bool WIN, bool VIMG = false> __device__ __forceinline__ void at_store(Frame& F, int tid, const AtUnit& u, const v4u (&reg)[12]) {
    int rs0, nlr, kc0; at_geom<WIN>(u, rs0, nlr, kc0);
    const int x = VIMG ? at_vswz(tid) : 0;
    if constexpr (WIN) {
#pragma unroll
        for (int jj = 0; jj < 8; ++jj) { const int n = tid + 512 * jj; if (n < nlr * 256) *(LAS v4u*)(F.lds + ((n * 16) ^ x)) = reg[jj]; }
    }
#pragma unroll
    for (int jj = 0; jj < 4; ++jj) { const int n = tid + 512 * jj; *(LAS v4u*)(F.lds + AT_CTX_OFF + ((n * 16) ^ x)) = reg[8 + jj]; }
}
#define AT_LDS_FRAG(off) (*(const LAS bf16x8*)(F.lds + (off)))
struct AtStat { float m1, l1, m2, l2; };
__device__ __forceinline__ float vmax3(float a, float b, float c) { float r; asm("v_max3_f32 %0, %1, %2, %3" : "=v"(r) : "v"(a), "v"(b), "v"(c)); return r; }
template <int NTILE> __device__ __forceinline__ void at_softmax_part(const f32x4 (&S)[NTILE], v4u* pw, float& m_out, float& l_out, int lane) {
    float ma = vmax3(S[0][0], S[0][1], S[0][2]), mb = vmax3(S[1][0], S[1][1], S[1][2]);
    ma = vmax3(ma, S[0][3], S[1][3]);
#pragma unroll
    for (int t = 2; t < NTILE; t += 2) { ma = vmax3(ma, S[t][0], S[t][1]); mb = vmax3(mb, S[t][2], S[t][3]); ma = vmax3(ma, S[t + 1][0], S[t + 1][1]); mb = vmax3(mb, S[t + 1][2], S[t + 1][3]); }
    float m = fmaxf(ma, mb);
    m = fmaxf(m, shx(m, 16, lane)); m = fmaxf(m, shx(m, 32, lane));
    const f32x2_t m2 = {m, m}; f32x2_t sum2 = {0.f, 0.f};
#pragma unroll
    for (int ks = 0; ks < NTILE / 2; ++ks) {
        unsigned w[4];
#pragma unroll
        for (int hh = 0; hh < 4; ++hh) {
            const f32x4 s4 = S[2 * ks + (hh >> 1)];
            const f32x2_t d = (f32x2_t){s4[2 * (hh & 1)], s4[2 * (hh & 1) + 1]} - m2;
            const f32x2_t pr = {__builtin_amdgcn_exp2f(d.x), __builtin_amdgcn_exp2f(d.y)};
            sum2 += pr; w[hh] = pk2(pr.x, pr.y);
        }
        pw[ks] = (v4u){w[0], w[1], w[2], w[3]};
    }
    float sum = sum2.x + sum2.y;
    sum += shx(sum, 16, lane); sum += shx(sum, 32, lane);
    m_out = m; l_out = sum;
}
__device__ __forceinline__ void at_build_bias(Frame& F, int tid, int c0, int kc0) {
    const LAS float* rpb = (const LAS float*)(F.lds + AT_RPB_OFF);
#pragma unroll
    for (int jj = 0; jj < 4; ++jj) { const int n = tid + 512 * jj;
        if (n < 15 * 128) { const int row = n >> 7, T = (n >> 6) & 1, kg = (n >> 4) & 3, q = n & 15;
            const int qcol = c0 + q, cs = qcol - 8 < 0 ? 0 : (qcol - 8 > 48 ? 48 : qcol - 8), kcol0 = kc0 + 8 * kg + 4 * T;
            f32x4 v;
#pragma unroll
            for (int e = 0; e < 4; ++e) { const int kcol = kcol0 + e; int rc = kcol - qcol + 15; rc = rc < 0 ? 0 : (rc > 30 ? 30 : rc);
                float bv = rpb[row * 31 + rc]; asm volatile("" : "+v"(bv));
                v[e] = (kcol >= cs && kcol < cs + 16) ? bv : -1e30f; }
            *(LAS f32x4*)(F.lds + AT_BX_OFF + n * 16) = v; } }
}
struct AtQ { bf16x8 w0, w1; };
template <bool WIN> __device__ __forceinline__ void at_load_q(Frame& F, int tid, const AtUnit& u, AtQ& Q) {
    const int lane = tid & 63, q = lane & 15, kg = lane >> 4;
    const int r = u.r0 + F.wave, h = u.bh & 15, b = u.bh >> 4;
    const size_t qrow = WIN ? (size_t)(b * SEQ + r * 64 + u.c0 + q) : (size_t)(u.qrow0 + 16 * F.wave + q);
    const bf16* qraw = F.Z() + qrow * PW + ZC_Q + 64 * h + 8 * kg;
    Q.w0 = ldfrag(qraw); Q.w1 = ldfrag(qraw + 32);
}
template <bool WIN> __device__ __forceinline__ void at_scores(Frame& F, int tid, const AtUnit& u, int L, const AtQ& Q, v4u* pw, AtStat& st, v4u (&rv)[12]) {
    const int lane = tid & 63, q = lane & 15, kg = lane >> 4;
    const f32x4 z4 = (f32x4){0.f, 0.f, 0.f, 0.f};
    int rs0, nlr, kc0; at_geom<WIN>(u, rs0, nlr, kc0);
    const int r = u.r0 + F.wave, rs = r - 4 < 0 ? 0 : (r - 4 > 24 ? 24 : r - 4), lr0 = rs - rs0;
    const int foff = (kg * 16 + q) * 16;
    st.m1 = -3e38f; st.l1 = 0.f;
    if constexpr (WIN) {
        const int boff = AT_BX_OFF + (rs - r + 7) * 2048 + foff;
        bf16x8 qr0, qr1;
        { const bool is_x2 = (kg >> 1) & 1; const int f0 = 8 * (kg & 1), qcol = u.c0 + q;
          const LAS f32x4* tr = (const LAS f32x4*)(F.lds + AT_ROPE_OFF + (r * 32 + 2 * f0) * 4); const LAS f32x4* tc = (const LAS f32x4*)(F.lds + AT_ROPE_OFF + (qcol * 32 + 2 * f0) * 4);
          f32x4 cr[4], cc[4];
#pragma unroll
          for (int e = 0; e < 4; ++e) { cr[e] = tr[e]; cc[e] = tc[e]; }
          const v4u a0 = __builtin_bit_cast(v4u, Q.w0), a1 = __builtin_bit_cast(v4u, Q.w1);
          v4u p0, p1; p0.x = shxu(a0.x, 32, lane); p0.y = shxu(a0.y, 32, lane); p0.z = shxu(a0.z, 32, lane); p0.w = shxu(a0.w, 32, lane);
          p1.x = shxu(a1.x, 32, lane); p1.y = shxu(a1.y, 32, lane); p1.z = shxu(a1.z, 32, lane); p1.w = shxu(a1.w, 32, lane);
          float x[8], pp[8], o[8];
          unpack8(a0, x); unpack8(p0, pp);
#pragma unroll
          for (int e = 0; e < 8; ++e) { const float c = cr[e >> 1][2 * (e & 1)], s = cr[e >> 1][2 * (e & 1) + 1]; o[e] = is_x2 ? (x[e] * c + pp[e] * s) : (x[e] * c - pp[e] * s); }
          qr0 = __builtin_bit_cast(bf16x8, pack8(o));
          unpack8(a1, x); unpack8(p1, pp);
#pragma unroll
          for (int e = 0; e < 8; ++e) { const float c = cc[e >> 1][2 * (e & 1)], s = cc[e >> 1][2 * (e & 1) + 1]; o[e] = is_x2 ? (x[e] * c + pp[e] * s) : (x[e] * c - pp[e] * s); }
          qr1 = __builtin_bit_cast(bf16x8, pack8(o)); }
        const int koff = lr0 * 4096 + foff;
        struct WT { bf16x8 k0, k1; f32x4 c; };
        WT wb[2][2];
#define AT_WLOAD(ir_, b_) do { _Pragma("unroll") for (int T = 0; T < 2; ++T) { const int to_ = koff + (ir_) * 4096 + T * 2048; (b_)[T].k0 = AT_LDS_FRAG(to_); (b_)[T].k1 = AT_LDS_FRAG(to_ + 1024); \
            (b_)[T].c = *(const LAS f32x4*)(F.lds + boff + (ir_) * 2048 + T * 1024); } } while (0)
        f32x4 S[16];
        AT_WLOAD(0, wb[0]);
#pragma unroll
        for (int ir = 0; ir < 8; ++ir) {
            if (ir + 1 < 8) AT_WLOAD(ir + 1, wb[(ir + 1) & 1]);
            __builtin_amdgcn_sched_barrier(0);
            const WT (&w)[2] = wb[ir & 1];
            const f32x4 a0 = mfma16(w[0].k0, qr0, w[0].c), a1 = mfma16(w[1].k0, qr0, w[1].c);
            S[2 * ir] = mfma16(w[0].k1, qr1, a0); S[2 * ir + 1] = mfma16(w[1].k1, qr1, a1);
            __builtin_amdgcn_sched_barrier(0);
        }
#undef AT_WLOAD
        at_softmax_part<16>(S, pw, st.m1, st.l1, lane);
    }
    {
        struct CT { bf16x8 k0, k1; };
        CT cb[2][2];
#define AT_CLOAD(s_, b_) do { _Pragma("unroll") for (int T = 0; T < 2; ++T) { const int to_ = AT_CTX_OFF + (2 * (s_) + T) * 2048 + foff; (b_)[T].k0 = AT_LDS_FRAG(to_); (b_)[T].k1 = AT_LDS_FRAG(to_ + 1024); } } while (0)
        f32x4 S[16];
        AT_CLOAD(0, cb[0]);
#pragma unroll
        for (int s = 0; s < 8; ++s) {
            if (s + 1 < 8) AT_CLOAD(s + 1, cb[(s + 1) & 1]);
            __builtin_amdgcn_sched_barrier(0);
            const CT (&w)[2] = cb[s & 1];
            const f32x4 a0 = mfma16(w[0].k0, Q.w0, z4), a1 = mfma16(w[1].k0, Q.w0, z4);
            S[2 * s] = mfma16(w[0].k1, Q.w1, a0); S[2 * s + 1] = mfma16(w[1].k1, Q.w1, a1);
            __builtin_amdgcn_sched_barrier(0);
        }
#undef AT_CLOAD
        at_softmax_part<16>(S, pw + (WIN ? 8 : 0), st.m2, st.l2, lane);
    }
}
template <bool WIN> __device__ __forceinline__ void at_pv(Frame& F, int tid, const AtUnit& u, const v4u* pw, const AtStat& st) {
    const int lane = tid & 63, q = lane & 15, kg = lane >> 4;
    const f32x4 z4 = (f32x4){0.f, 0.f, 0.f, 0.f};
    int rs0, nlr, kc0; at_geom<WIN>(u, rs0, nlr, kc0);
    const int r = u.r0 + F.wave, rs = r - 4 < 0 ? 0 : (r - 4 > 24 ? 24 : r - 4), lr0 = rs - rs0;
    const int h = u.bh & 15, b = u.bh >> 4;
    typedef short s4v __attribute__((ext_vector_type(4)));
    const int qq = (lane >> 2) & 3, pp = lane & 3, sgm = ((qq >> 1) & 1) | ((kg & 1) << 1);
    const int rowoff = (8 * kg + qq) * 128 + 8 * pp;
    constexpr int NKS = WIN ? 16 : 8;
    const int wbase = lr0 * 4096 + rowoff, cbase = AT_CTX_OFF + rowoff;
    f32x4 O[4] = {z4, z4, z4, z4}, Ow[4] = {z4, z4, z4, z4};
    bf16x8 vf[3][4];
#define AT_VLOAD(ks_, b_) do { const int vo_ = (WIN && (ks_) < 8) ? wbase + (ks_) * 4096 : cbase + ((ks_) - (WIN ? 8 : 0)) * 4096; \
        _Pragma("unroll") for (int dt = 0; dt < 4; ++dt) { const int a_ = vo_ + ((dt ^ sgm) << 5); \
            const s4v lo_ = __builtin_amdgcn_ds_read_tr16_b64_v4i16((LAS s4v*)(F.lds + a_)), hi_ = __builtin_amdgcn_ds_read_tr16_b64_v4i16((LAS s4v*)(F.lds + a_ + 512)); \
            (b_)[dt] = __builtin_shufflevector(lo_, hi_, 0, 1, 2, 3, 4, 5, 6, 7); } } while (0)
    AT_VLOAD(0, vf[0]); AT_VLOAD(1, vf[1]);
#pragma unroll
    for (int ks = 0; ks < NKS; ++ks) {
        if (ks + 2 < NKS) AT_VLOAD(ks + 2, vf[(ks + 2) % 3]);
        __builtin_amdgcn_sched_barrier(0);
        const bf16x8 pf = __builtin_bit_cast(bf16x8, pw[ks]);
        if (WIN && ks < 8) {
#pragma unroll
            for (int dt = 0; dt < 4; ++dt) Ow[dt] = mfma16(vf[ks % 3][dt], pf, Ow[dt]);
        } else {
#pragma unroll
            for (int dt = 0; dt < 4; ++dt) O[dt] = mfma16(vf[ks % 3][dt], pf, O[dt]);
        }
        __builtin_amdgcn_sched_barrier(0);
    }
#undef AT_VLOAD
    float lsum = st.l2;
    if constexpr (WIN) {
        const float m = fmaxf(st.m1, st.m2), f1 = __builtin_amdgcn_exp2f(st.m1 - m), f2 = __builtin_amdgcn_exp2f(st.m2 - m);
#pragma unroll
        for (int dt = 0; dt < 4; ++dt) O[dt] = O[dt] * f2 + Ow[dt] * f1;
        lsum = st.l2 * f2 + st.l1 * f1;
    }
    const float inv = __builtin_amdgcn_rcpf(lsum);
    const size_t orow = WIN ? (size_t)(b * SEQ + r * 64 + u.c0 + q) : (size_t)(u.qrow0 + 16 * F.wave + q);
    bf16* out = F.MIX() + orow * DM + 512 + 64 * h + 4 * kg;
#pragma unroll
    for (int dt = 0; dt < 4; ++dt) { v2u w; w.x = pk2(O[dt][0] * inv, O[dt][1] * inv); w.y = pk2(O[dt][2] * inv, O[dt][3] * inv); *(v2u*)(out + 16 * dt) = w; }
}
#undef AT_LDS_FRAG
#define AT_BAR() asm volatile("s_waitcnt lgkmcnt(0)\n\ts_barrier" ::: "memory")
template <bool WIN, bool QUEUE, class UnitFn> __device__ __forceinline__ void attn_units(Frame& F, int L, int nunits, UnitFn unit_of, unsigned* qctr) {
    if (nunits <= 0) return;
    v4u rk[12], rv[12]; float rpbv = 0.f;
    volatile LAS int* qslot = (volatile LAS int*)(F.lds + AT_RPB_OFF + 2048);
    int cur = 0, nxt = 1;
    if constexpr (QUEUE) {
        if (F.tid == 0) { qslot[0] = (int)__hip_atomic_fetch_add(qctr, 1u, __ATOMIC_RELAXED, __HIP_MEMORY_SCOPE_AGENT); qslot[1] = (int)__hip_atomic_fetch_add(qctr, 1u, __ATOMIC_RELAXED, __HIP_MEMORY_SCOPE_AGENT); }
        __syncthreads();
        cur = __builtin_amdgcn_readfirstlane(qslot[0]); nxt = __builtin_amdgcn_readfirstlane(qslot[1]);
        __syncthreads();
        if (cur >= nunits) return;
    }
    if constexpr (WIN) *(LAS f32x4*)(F.lds + AT_ROPE_OFF + F.tid * 16) = *(const f32x4*)(F.ROPE() + F.tid * 4);
    AtUnit u = unit_of(cur);
#define AT_OPQ(x) ({ int o_ = (x); asm volatile("" : "+v"(o_)); o_; })
    at_load_k<WIN>(F, AT_OPQ(F.tid), u, rk, rpbv, L);
    AtQ Q; at_load_q<WIN>(F, AT_OPQ(F.tid), u, Q);
    int bx_h = -1, bx_c0 = -1;
#pragma unroll 1
    for (;;) {
        const int tid = AT_OPQ(F.tid);
        int nn = nxt + 1;
        int fetched = 0;
        if constexpr (QUEUE) { if (tid == 0) { int zo_ = 0; asm volatile("" : "+v"(zo_));
                fetched = (int)__hip_atomic_fetch_add(qctr + zo_, 1u, __ATOMIC_RELAXED, __HIP_MEMORY_SCOPE_AGENT); } }
        AT_BAR();
        at_store<WIN>(F, AT_OPQ(tid), u, rk);
        if (WIN && tid < 465) *(LAS float*)(F.lds + AT_RPB_OFF + 4 * tid) = rpbv * 1.4426950408889634f;
        at_load_v<WIN>(F, AT_OPQ(tid), u, rv);
        if constexpr (WIN) { const AtUnit un0 = unit_of(nxt < nunits ? nxt : cur); at_load_k<WIN, 2>(F, AT_OPQ(tid), un0, rk, rpbv, L); }
        __builtin_amdgcn_sched_barrier(0);
        AT_BAR();
        if constexpr (WIN) {
            const int hh_ = u.bh & 15; if (hh_ != bx_h || u.c0 != bx_c0) { int rs0_, nlr_, kc0_; at_geom<WIN>(u, rs0_, nlr_, kc0_); at_build_bias(F, AT_OPQ(tid), u.c0, kc0_); AT_BAR(); bx_h = hh_; bx_c0 = u.c0; } }
        v4u pw[WIN ? 16 : 8]; AtStat st;
        at_scores<WIN>(F, AT_OPQ(tid), u, L, Q, pw, st, rv);
        if constexpr (QUEUE) { if (tid == 0) qslot[0] = fetched; }
        AT_BAR();
        if constexpr (QUEUE) nn = __builtin_amdgcn_readfirstlane(qslot[0]);
        const bool more = nxt < nunits;
        const AtUnit un = unit_of(more ? nxt : cur);
        at_store<WIN, true>(F, AT_OPQ(tid), u, rv);
        if constexpr (WIN) at_load_k<WIN, 1>(F, AT_OPQ(tid), un, rk, rpbv, L); else at_load_k<WIN>(F, AT_OPQ(tid), un, rk, rpbv, L);
        at_load_q<WIN>(F, AT_OPQ(tid), un, Q);
        AT_BAR();
        at_pv<WIN>(F, AT_OPQ(tid), u, pw, st);
        if (!more) break;
        u = un; cur = nxt; nxt = nn;
    }
    __syncthreads();
}
#undef AT_OPQ
#undef AT_BAR

constexpr int SG_ROW = 132;
__device__ __forceinline__ void sgu_unit(Frame& F, int L, int ck) {
    const int lane = F.lane, w = F.wave; const size_t row0 = (size_t)128 * ck;
    LAS bf16* vnT = (LAS bf16*)F.lds;
    const float* lg = F.inp(I_SLG) + (size_t)L * 512 + 8 * lane; const float* lb = F.inp(I_SLB) + (size_t)L * 512 + 8 * lane;
    float g8[8], b8[8];
#pragma unroll
    for (int e = 0; e < 8; ++e) { g8[e] = lg[e]; b8[e] = lb[e]; }
    for (int t4 = 0; t4 < 4; ++t4) {
        float x[4][8], s[4], q[4];
#pragma unroll
        for (int i = 0; i < 4; ++i) unpack8(*(const v4u*)(F.Z() + (row0 + 16 * w + 4 * t4 + i) * PW + ZC_SV + 8 * lane), x[i]);
#pragma unroll
        for (int i = 0; i < 4; ++i) { s[i] = 0.f;
#pragma unroll
            for (int e = 0; e < 8; ++e) { x[i][e] = gelu_t(x[i][e]); s[i] += x[i][e]; } }
#pragma unroll
        for (int o = 1; o < 64; o <<= 1)
#pragma unroll
            for (int i = 0; i < 4; ++i) s[i] += shx(s[i], o, lane);
#pragma unroll
        for (int i = 0; i < 4; ++i) { const float mean = s[i] * (1.0f / 512.0f); q[i] = 0.f;
#pragma unroll
            for (int e = 0; e < 8; ++e) { x[i][e] -= mean; q[i] += x[i][e] * x[i][e]; } }
#pragma unroll
        for (int o = 1; o < 64; o <<= 1)
#pragma unroll
            for (int i = 0; i < 4; ++i) q[i] += shx(q[i], o, lane);
#pragma unroll
        for (int i = 0; i < 4; ++i) { const int tok = 16 * w + 4 * t4 + i; const float rstd = __builtin_amdgcn_rsqf(q[i] * (1.0f / 512.0f) + NORM_EPS);
#pragma unroll
            for (int e = 0; e < 8; ++e) { const int e2 = (e + lane) & 7;
                float val = 0.f;
#pragma unroll
                for (int k = 0; k < 8; ++k) if (k == e2) val = x[i][k] * rstd * g8[k] + b8[k];
                vnT[(8 * lane + e2) * SG_ROW + tok] = (bf16)f2bf(val); } }
    }
    __syncthreads();
    {
        const int g = w, dl = lane & 15, kg = lane >> 4;
        typedef unsigned long long u64;
        bf16x8 A[4][4];
#pragma unroll
        for (int dt = 0; dt < 4; ++dt)
#pragma unroll
            for (int ks = 0; ks < 4; ++ks) { const LAS u64* p = (const LAS u64*)(vnT + (64 * g + 16 * dt + dl) * SG_ROW + 32 * ks + 8 * kg);
                const u64 lo = p[0], hi = p[1]; v4u wv; wv.x = (unsigned)lo; wv.y = (unsigned)(lo >> 32); wv.z = (unsigned)hi; wv.w = (unsigned)(hi >> 32); A[dt][ks] = __builtin_bit_cast(bf16x8, wv); }
        const bf16* Wg = F.SWB() + ((size_t)L * 8 + g) * 16384; const float* sb = F.inp(I_SB) + ((size_t)L * 8 + g) * 128;
        struct SgOps { bf16x8 Bf[4]; float bias; v2u uw[4]; };
        SgOps so[2];
#define SG_LOAD(pt_, o_) do { const int p_ = 16 * (pt_) + dl; \
            _Pragma("unroll") for (int ks = 0; ks < 4; ++ks) (o_).Bf[ks] = ldfrag(Wg + p_ * 128 + 32 * ks + 8 * kg); \
            (o_).bias = sb[p_]; \
            _Pragma("unroll") for (int dt = 0; dt < 4; ++dt) (o_).uw[dt] = *(const v2u*)(F.Z() + (row0 + p_) * PW + ZC_SU + 64 * g + 16 * dt + 4 * kg); } while (0)
        SG_LOAD(0, so[0]);
#pragma unroll
        for (int pt = 0; pt < 8; ++pt) {
            if (pt + 1 < 8) SG_LOAD(pt + 1, so[(pt + 1) & 1]);
            __builtin_amdgcn_sched_barrier(0);
            const SgOps& o = so[pt & 1]; const int p = 16 * pt + dl;
#pragma unroll
            for (int dt = 0; dt < 4; ++dt) {
                f32x4 acc = (f32x4){0.f, 0.f, 0.f, 0.f};
#pragma unroll
                for (int ks = 0; ks < 4; ++ks) acc = mfma16(A[dt][ks], o.Bf[ks], acc);
                const int d = 64 * g + 16 * dt + 4 * kg; const v2u uw = o.uw[dt];
                const float o0 = gelu_t(bflo(uw.x)) * (acc[0] + o.bias), o1 = gelu_t(bfhi(uw.x)) * (acc[1] + o.bias), o2 = gelu_t(bflo(uw.y)) * (acc[2] + o.bias), o3 = gelu_t(bfhi(uw.y)) * (acc[3] + o.bias);
                v2u ow; ow.x = pk2(o0, o1); ow.y = pk2(o2, o3);
                *(v2u*)(F.MIX() + (row0 + p) * DM + 1536 + d) = ow;
            }
            __builtin_amdgcn_sched_barrier(0);
        }
#undef SG_LOAD
    }
    __syncthreads();
}

#ifndef MK_PER_PHASE
#define MK_PER_PHASE 0
#endif
constexpr int PH_PER_LAYER = 9, NPH = 2 + DEPTH * PH_PER_LAYER + 1;

struct OffOrder : pg8::StaticOrder { int pm0;
    __device__ __forceinline__ bool next(int i, pg8::Unit& u) const { const bool ok = pg8::StaticOrder::next(i, u); u.pm += pm0; return ok; } };

__global__ void __launch_bounds__(NTHREADS, 2) fwd_kernel(Args args) {
    extern __shared__ __attribute__((aligned(16))) unsigned char lds_raw[];
    Frame F;
    F.lds = (LAS unsigned char*)lds_raw;
    F.tid = threadIdx.x; F.lane = F.tid & 63; F.wave = __builtin_amdgcn_readfirstlane(F.tid >> 6); F.G = gridDim.x; F.bid = blockIdx.x;
    F.ws = args.ws; F.out = args.out;
    unsigned char* ws = args.ws;
    if (F.tid == 0) {
#pragma unroll
        for (int i = 0; i < 25; ++i) *(LAS unsigned long long*)(F.lds + PTR_OFF + 8 * i) = (unsigned long long)args.in[i];
    }
    volatile LAS unsigned* MISC = (volatile LAS unsigned*)(F.lds + MISC_OFF);
    if (F.tid < 32) MISC[F.tid] = 0u;
    __syncthreads();
    XcdBarrier bar; bar.bar = (unsigned*)(ws + WS_CTL) + CW_BAR; bar.x = 0; bar.st = nullptr;
    if (!MK_PER_PHASE) bar = xcd_barrier_post((unsigned*)(ws + WS_CTL) + CW_BAR, MISC + 8);
    const int lo = args.ph_lo, hi = args.ph_hi;
    const int wave_s = __builtin_amdgcn_readfirstlane(threadIdx.x >> 6);
#ifndef PH_MASK
#define PH_MASK 0x7ff
#endif
#define KIND(k) ((k) == 0 ? 0 : ((k) == NPH - 1 ? 10 : 1 + ((k) - 1) % PH_PER_LAYER))
#define IN(k) (lo <= (k) && (k) < hi)
#ifndef SUB_TWICE
#define SUB_TWICE 0
#endif
#define SUBREPS(bit) for (int srep_ = 0; srep_ < 1 + ((SUB_TWICE >> (bit)) & 1); ++srep_)
#ifndef PH_TWICE
#define PH_TWICE 0
#endif
#define REPS(kind) for (int rep_ = 0, nrep_ = 1 + ((PH_TWICE >> (kind)) & 1); rep_ < nrep_; ++rep_)
#define GATE(p) ((PH_TWICE && rep_) ? (const float*)(ws + WS_CTL + 262144) : (p))
#define REP_SYNC() do { if (PH_TWICE && rep_ + 1 < nrep_ && !MK_PER_PHASE) xcd_barrier(bar, F.tid); } while (0)
#define PHASE_BEGIN() do { int l_; asm volatile("v_mbcnt_lo_u32_b32 %0, -1, 0\n\tv_mbcnt_hi_u32_b32 %0, -1, %0" : "=v"(l_)); F.lane = l_; F.wave = wave_s; F.tid = wave_s * 64 + l_; size_t z_ = 0; asm volatile("" : "+s"(z_)); unsigned char* w_ = args.ws + z_; F.ws = w_; ws = w_;     int g_ = gridDim.x, b_ = blockIdx.x; asm volatile("" : "+s"(g_), "+s"(b_)); F.G = g_; F.bid = b_; } while (0)
#define LANE_REFRESH() do { int l_; asm volatile("v_mbcnt_lo_u32_b32 %0, -1, 0\n\tv_mbcnt_hi_u32_b32 %0, -1, %0" : "=v"(l_)); F.lane = l_; F.tid = wave_s * 64 + l_; } while (0)
#define SEAM(k) do { if (!MK_PER_PHASE && IN(k) && IN((k) + 1)) xcd_barrier(bar, F.tid); } while (0)

    const bool G256 = (F.G == 256);
    if (((PH_MASK >> 0) & 1) && IN(0)) { REPS(0) { PHASE_BEGIN(); p0_prologue(F); REP_SYNC(); } SEAM(0); }
    if (IN(1)) { PHASE_BEGIN(); int r0, r1; share(MLAT, MALL, F.bid, F.G, r0, r1); norm_range(F, 0, 0, r0, r1); SEAM(1); }

    for (int L = 0; L < DEPTH; ++L) {
        const int pb = 2 + PH_PER_LAYER * L;
        const bool lastL = (L == DEPTH - 1);
        const bf16* wt = (const bf16*)(ws + WS_WT + (size_t)L * WT_LAYER);
        const float* modL = F.MOD() + (size_t)L * 9 * MODW;

        if (((PH_MASK >> 1) & 1) && IN(pb + 0)) { REPS(1) { PHASE_BEGIN();
            { pg8::Gemm g{F.HX(), (const bf16*)((const char*)wt + WT_IN), MCTX, PW, DM}; OffOrder S; S.init(MCTX, PW, F.G, F.bid); S.pm0 = 64;
              pg8::EpiBf16<0> E{F.Z(), PW, nullptr, 0, 0, 1.f};
              pg8::gemm_phase<pg8::EpiBf16<0>, OffOrder, true, true>(F.lds, g, S, E, F.tid); }
            int r0, r1;
            if (G256) { if (F.bid < 160) { r0 = 16 * F.bid; r1 = r0 + 16; } else { r0 = 2560 + 144 * (F.bid - 160); r1 = r0 + 144; if (r0 > MLAT) r0 = MLAT; if (r1 > MLAT) r1 = MLAT; } }
            else share(0, MLAT, F.bid, F.G, r0, r1);
            norm_range(F, L, 0, r0, r1);
            REP_SYNC(); }
            SEAM(pb + 0);
        }

        if (((PH_MASK >> 2) & 1) && IN(pb + 1)) { REPS(2) { PHASE_BEGIN();
            { pg8::Gemm g{F.HX(), (const bf16*)((const char*)wt + WT_IN), MLAT, PW, DM}; pg8::StaticOrder S; S.init(MLAT, PW, F.G, F.bid);
              pg8::EpiBf16<0> E{F.Z(), PW, nullptr, 0, 0, 1.f};
              pg8::gemm_phase<pg8::EpiBf16<0>, pg8::StaticOrder, true, true>(F.lds, g, S, E, F.tid); }
            __syncthreads();
            for (int u = 1024 + F.bid; u < 1152; u += F.G) lru_ab_unit(F, L, u);
            if (!G256 || F.bid >= 128) for (int wu = (G256 ? F.bid - 128 : F.bid) * NWAVES + F.wave; wu < 512; wu += (G256 ? F.G - 128 : F.G) * NWAVES) prep_unit(F, true, wu >> 6, (wu >> 2) & 15, wu & 3);
            REP_SYNC(); }
            SEAM(pb + 1);
        }

        if (((PH_MASK >> 3) & 1) && IN(pb + 2)) { REPS(3) { PHASE_BEGIN();
            if (G256 && !lastL) { const int nmine = F.bid >= 240 ? 2 : 4;
                for (int k = 0; k < nmine; ++k) lru_ab_unit(F, L, F.bid + 256 * k);
                if (F.bid >= 128 && F.bid < 144) lru_ab_unit(F, L, 240 + (F.bid - 128) + 256 * 3);
                if (F.bid >= 144 && F.bid < 160) lru_ab_unit(F, L, 240 + (F.bid - 144) + 256 * 2); }
            else for (int u = F.bid; u < 1024; u += F.G) lru_ab_unit(F, L, u);
            for (int wu = F.bid * NWAVES + F.wave; wu < 4096; wu += F.G * NWAVES) prep_unit(F, false, wu >> 9, (wu >> 5) & 15, wu & 31);
            if (!lastL) {
                for (int u = 1024 + F.bid; u < 1152; u += F.G) lru_d_unit(F, u);
                __syncthreads();
                LANE_REFRESH();
                const int xcd = F.bid & 7, slot = F.bid >> 3;
                attn_units<false, false>(F, L, G256 ? 1 : (256 - F.bid + F.G - 1) / F.G, [&](int i) { const int uu = G256 ? (xcd * 16 + (slot >> 1)) * 2 + (slot & 1) : F.bid + i * F.G; const int bh = uu >> 1;
                    return AtUnit{bh, 0, 0, MLAT + (bh >> 4) * CTXL + 128 * (uu & 1)}; }, nullptr);
                __syncthreads();
                LANE_REFRESH();
                if (F.G >= 16) { if (F.bid >= F.G - 16) sgu_unit(F, L, 128 + F.bid - (F.G - 16)); } else for (int uu = 128 + F.bid; uu < 144; uu += F.G) sgu_unit(F, L, uu);
            }
            REP_SYNC(); }
            SEAM(pb + 2);
        }

        if (((PH_MASK >> 4) & 1) && IN(pb + 3)) { REPS(4) { PHASE_BEGIN();
            if (!lastL) { pg8::Gemm g{F.MIX(), (const bf16*)((const char*)wt + WT_OUT), MCTX, DM, DM}; OffOrder S; S.init(MCTX, DM, F.G, F.bid); S.pm0 = 64;
              const bool in32 = (L == 0 && !(PH_TWICE && rep_)); pg8::EpiResGateB16 E{in32 ? F.inp(I_X) : nullptr, in32 ? F.inp(I_CTX) - (size_t)MLAT * DM : nullptr, F.X(), F.X(), GATE(modL + 2 * DM)};
              pg8::gemm_phase<pg8::EpiResGateB16, OffOrder, true, true>(F.lds, g, S, E, F.tid);
              __syncthreads(); }
            {
            SUBREPS(4) for (int u = F.bid; u < 1024; u += F.G) lru_d_unit(F, u);
            __syncthreads();
            LANE_REFRESH();
            SUBREPS(5) { if (F.G >= 128) { if (F.bid >= F.G - 128) sgu_unit(F, L, F.bid - (F.G - 128)); } else for (int uu = F.bid; uu < 128; uu += F.G) sgu_unit(F, L, uu); }
            __syncthreads();
            LANE_REFRESH();
            SUBREPS(2) { const bool grp = (F.G % 8 == 0); const int xg = grp ? (F.bid & 7) : 0; unsigned* qc = (unsigned*)(ws + WS_CTL) + CW_Q + (L * 8 + xg) * 64 + 2048 * (srep_ + rep_);
              attn_units<true, true>(F, L, grp ? 256 : 2048, [&](int n) {
                const int bl = n >> 4, bh = grp ? ((bl >> 1) * 16 + 2 * xg + (bl & 1)) : bl, sub = n & 15;
                return AtUnit{bh, 8 * (sub >> 2), 16 * (sub & 3), 0}; }, qc); }
            }
            REP_SYNC(); }
            SEAM(pb + 3);
        }

        if (((PH_MASK >> 5) & 1) && IN(pb + 4)) { REPS(5) { PHASE_BEGIN();
            { pg8::Gemm g{F.MIX(), (const bf16*)((const char*)wt + WT_OUT), MLAT, DM, DM}; pg8::StaticOrder S; S.init(MLAT, DM, F.G, F.bid);
              const bool in32 = (L == 0 && !(PH_TWICE && rep_)); pg8::EpiResGateB16 E{in32 ? F.inp(I_X) : nullptr, in32 ? F.inp(I_CTX) - (size_t)MLAT * DM : nullptr, F.X(), F.X(), GATE(modL + 2 * DM)};
              pg8::gemm_phase<pg8::EpiResGateB16, pg8::StaticOrder, true, true>(F.lds, g, S, E, F.tid); }
            if (!lastL) { int r0, r1; share(MLAT, MALL, F.bid, F.G, r0, r1); norm_range(F, L, 1, r0, r1); }
            REP_SYNC(); }
            SEAM(pb + 4);
        }

        if (((PH_MASK >> 6) & 1) && IN(pb + 5)) { REPS(6) { PHASE_BEGIN();
            int r0, r1;
            if (!lastL) { pg8::Gemm g{F.HX(), (const bf16*)((const char*)wt + WT_UP), MCTX, FU, DM}; OffOrder S; S.init(MCTX, FU, F.G, F.bid); S.pm0 = 64;
              pg8::EpiBf16<0> E{F.U(), FU, nullptr, 0, 0, 1.f};
              pg8::gemm_phase<pg8::EpiBf16<0>, OffOrder, true, true>(F.lds, g, S, E, F.tid);
              if (G256) { if (F.bid < 88) { r0 = 0; r1 = 0; } else share(0, MLAT, F.bid - 88, 168, r0, r1); } else share(0, MLAT, F.bid, F.G, r0, r1); }
            else share(0, MLAT, F.bid, F.G, r0, r1);
            norm_range(F, L, 1, r0, r1);
            REP_SYNC(); }
            SEAM(pb + 5);
        }

        if (((PH_MASK >> 7) & 1) && IN(pb + 6)) { REPS(7) { PHASE_BEGIN();
            { pg8::Gemm g{F.HX(), (const bf16*)((const char*)wt + WT_UP), MLAT, FU, DM}; pg8::StaticOrder S; S.init(MLAT, FU, F.G, F.bid);
              pg8::EpiBf16<0> E{F.U(), FU, nullptr, 0, 0, 1.f};
              pg8::gemm_phase<pg8::EpiBf16<0>, pg8::StaticOrder, true, true>(F.lds, g, S, E, F.tid); }
            if (!lastL) { if (G256) convgate_phase(F, L, MLAT, MALL, 192, 64); else convgate_phase(F, L, MLAT, MALL, 0, F.G); }
            REP_SYNC(); }
            SEAM(pb + 6);
        }

        if (((PH_MASK >> 8) & 1) && IN(pb + 7)) { REPS(8) { PHASE_BEGIN();
            if (!lastL) { pg8::Gemm g{F.ACT(), (const bf16*)((const char*)wt + WT_DN), MCTX, DM, FH}; OffOrder S; S.init(MCTX, DM, F.G, F.bid); S.pm0 = 64;
              pg8::EpiResGateB16 E{nullptr, nullptr, F.X(), F.X(), GATE(modL + 5 * DM)};
              pg8::gemm_phase<pg8::EpiResGateB16, OffOrder, true, true>(F.lds, g, S, E, F.tid); }
            SUBREPS(3) { if (G256 && !lastL) convgate_phase(F, L, 0, MLAT, 64, 192); else convgate_phase(F, L, 0, MLAT, 0, F.G); }
            REP_SYNC(); }
            SEAM(pb + 7);
        }

        if (((PH_MASK >> 9) & 1) && IN(pb + 8)) { REPS(9) { PHASE_BEGIN();
            { pg8::Gemm g{F.ACT(), (const bf16*)((const char*)wt + WT_DN), MLAT, DM, FH}; pg8::StaticOrder S; S.init(MLAT, DM, F.G, F.bid);
              pg8::EpiResGateB16 E{nullptr, nullptr, F.X(), F.X(), GATE(modL + 5 * DM)};
              pg8::gemm_phase<pg8::EpiResGateB16, pg8::StaticOrder, true, true>(F.lds, g, S, E, F.tid); }
            if (!lastL) { int r0, r1; share(MLAT, MALL, F.bid, F.G, r0, r1); norm_range(F, L + 1, 0, r0, r1); }
            REP_SYNC(); }
            SEAM(pb + 8);
        }
    }
    if (((PH_MASK >> 10) & 1) && IN(NPH - 1)) { PHASE_BEGIN(); final_norm_phase(F); }
#ifdef EXTRA_BARS
    if (!MK_PER_PHASE) for (int eb = 0; eb < EXTRA_BARS; ++eb) xcd_barrier(bar, F.tid);
#endif
#undef IN
#undef SEAM
}

extern "C" void kernel_launch(void* const* d_in, const int* in_sizes, int n_in, void* d_out, int out_size, void* d_ws, size_t ws_size, hipStream_t stream) {
    static int grid = 0;
    if (grid == 0) {
        if (n_in != 25 || out_size != MLAT * DM || ws_size < WS_END) { fprintf(stderr, "kernel_launch: unexpected shapes (n_in %d, out %d, ws %zu)\n", n_in, out_size, ws_size); grid = -1; return; }
        int dev = 0, cus = 0, per_cu = 0;
        if (hipGetDevice(&dev) != hipSuccess || hipDeviceGetAttribute(&cus, hipDeviceAttributeMultiprocessorCount, dev) != hipSuccess) { grid = -1; return; }
        if (hipFuncSetAttribute((const void*)fwd_kernel, hipFuncAttributeMaxDynamicSharedMemorySize, LDS_BYTES) != hipSuccess) { fprintf(stderr, "kernel_launch: hipFuncSetAttribute failed\n"); grid = -1; return; }
        if (hipOccupancyMaxActiveBlocksPerMultiprocessor(&per_cu, (const void*)fwd_kernel, NTHREADS, LDS_BYTES) != hipSuccess || per_cu < 1) { fprintf(stderr, "kernel_launch: occupancy query says %d\n", per_cu); }
        (void)hipGetLastError();
        grid = cus;
    }
    if (grid < 0) return;
    if (hipMemsetAsync((char*)d_ws + WS_CTL, 0, CTL_ZERO_BYTES, stream) != hipSuccess) return;
    Args a{};
    for (int i = 0; i < 25; ++i) a.in[i] = (const float*)d_in[i];
    a.out = (float*)d_out; a.ws = (unsigned char*)d_ws;
#if MK_PER_PHASE
    for (int p = 0; p < NPH; ++p) { a.ph_lo = p; a.ph_hi = p + 1; hipLaunchKernelGGL(fwd_kernel, dim3(grid), dim3(NTHREADS), LDS_BYTES, stream, a); }
#else
    a.ph_lo = 0; a.ph_hi = NPH;
    hipLaunchKernelGGL(fwd_kernel, dim3(grid), dim3(NTHREADS), LDS_BYTES, stream, a);
#endif
    const hipError_t le = hipPeekAtLastError();
    if (le != hipSuccess) fprintf(stderr, "kernel_launch: launch failed: %s\n", hipGetErrorName(le));
}
```

```cpp
#include <hip/hip_runtime.h>
#include <cstdio>
#include <cstdint>
namespace pg8 {
#define PG8_LAS __attribute__((address_space(3)))
typedef unsigned short bf16_t;
typedef short bf16x8 __attribute__((ext_vector_type(8)));
typedef float f32x4 __attribute__((ext_vector_type(4)));
typedef unsigned u32x4 __attribute__((ext_vector_type(4)));
constexpr int BM = 256, BK = 64, HALF = 128, HTB = HALF * BK * 2  , STAGE_BYTES = 8 * HTB, NXCD = 8, WGM = 8;

__host__ __device__ __forceinline__ int lds_byte(int r, int c) { const int st = (r >> 4) * 2 + (c >> 5), rr = r & 15, cc = c & 31, ob = rr * 64 + cc * 2; return st * 1024 + (ob ^ (((ob >> 9) & 1) << 5)); }
__host__ __device__ __forceinline__ void stage_rc(int b, int& R, int& C) { const int st = b / 1024, sb = b % 1024, swz = sb ^ (((sb >> 9) & 1) << 5); R = (st >> 1) * 16 + swz / 64; C = (st & 1) * 32 + (swz % 64) / 2; }
__host__ __device__ __forceinline__ int perm32(int rho) { const int n = rho >> 4, i = rho & 15; return 8 * (i >> 2) + 4 * n + (i & 3); }

struct Unit { int pm, pn; };
struct Gemm { const bf16_t* A; const bf16_t* Bt; int M, N, K; };

struct StaticOrder {
    int nM, nN, nwg, G, c;
    __host__ __device__ void init(int M, int N, int G_, int c_) { nM = M / BM; nN = N / BM; nwg = nM * nN; G = G_; c = c_; }
    __host__ __device__ bool next(int i, Unit& u) const {
        const long L = (long)i * G + c; if (L >= nwg) return false;
        int wgid = (int)L; { const int q = nwg / NXCD, r = nwg % NXCD, xcd = wgid % NXCD, off = wgid / NXCD; wgid = (xcd < r ? xcd * (q + 1) : r * (q + 1) + (xcd - r) * q) + off; }
        const int nig = WGM * nN, gid = wgid / nig, fm = gid * WGM, gsz = (nM - fm) < WGM ? (nM - fm) : WGM;
        u.pm = fm + ((wgid % nig) % gsz); u.pn = (wgid % nig) / gsz; return true;
    }
    __device__ __forceinline__ void a_ready(const Unit&) const {}
    __device__ __forceinline__ void done(const Unit&) const {}
};

__device__ __forceinline__ unsigned cvt_pk_bf16(float lo, float hi) { unsigned r; asm volatile("v_cvt_pk_bf16_f32 %0, %1, %2" : "=v"(r) : "v"(lo), "v"(hi)); return r; }
typedef float f32x2 __attribute__((ext_vector_type(2)));
__device__ __forceinline__ f32x2 gelu_pk(f32x2 v) {
    const f32x2 av = __builtin_elementwise_abs(v), d = av * 0.2316418882f + 1.0f;
    f32x2 t; t.x = __builtin_amdgcn_rcpf(d.x); t.y = __builtin_amdgcn_rcpf(d.y);
    f32x2 q = t * 0.5307027145f + (-0.7265760135f); q = q * t + 0.7107068705f; q = q * t + (-0.142248368f); q = q * t + 0.127414796f; q = q * t;
    const f32x2 s = (v * v) * (-0.72134752044f);
    f32x2 e; e.x = __builtin_amdgcn_exp2f(s.x); e.y = __builtin_amdgcn_exp2f(s.y);
    const f32x2 m = v * (q * e), r = v - m;
    f32x2 o; o.x = v.x < 0.f ? m.x : r.x; o.y = v.y < 0.f ? m.y : r.y; return o;
}

template <int ACT  > struct EpiBf16 {
    static constexpr bool PERM = true, AFTER_DRAIN = false; static_assert(ACT == 0 || ACT == 1, "EpiBf16: ACT is 0 (none) or 1 (gelu_pk)");
    bf16_t* O; int ldc; const float* bias; int split_cols; size_t split_stride; float scale0;
    __device__ __forceinline__ void operator()(const f32x4 (&acc)[2][2][4][2], const Unit& u, int wr, int wc, int fr, int fq) const {
        const int row0 = u.pm * BM + wr * 64 + fr; int colt = u.pn * BM; bf16_t* base = O;
        float sc = 1.f; if (split_cols) { const int t = colt / split_cols; base += (size_t)t * split_stride; colt -= t * split_cols; if (t == 0) sc = scale0; }
        const int col0 = colt + wc * 32 + 8 * fq, bcol0 = u.pn * BM + wc * 32 + 8 * fq;
        f32x4 bv[2][2];
#pragma unroll
        for (int bj = 0; bj < 2; ++bj)
#pragma unroll
            for (int n = 0; n < 2; ++n) bv[bj][n] = bias ? *(const f32x4*)(bias + bcol0 + bj * HALF + 4 * n) : (f32x4){0.f, 0.f, 0.f, 0.f};
#pragma unroll
        for (int ai = 0; ai < 2; ++ai)
#pragma unroll
            for (int m = 0; m < 4; ++m) { bf16_t* rowp = base + (size_t)(row0 + ai * HALF + m * 16) * ldc + col0;
#pragma unroll
                for (int bj = 0; bj < 2; ++bj) { f32x4 v0 = acc[ai][bj][m][0] + bv[bj][0], v1 = acc[ai][bj][m][1] + bv[bj][1];
                    if (ACT == 1) { f32x2 a = gelu_pk((f32x2){v0[0], v0[1]}), b = gelu_pk((f32x2){v0[2], v0[3]}), c = gelu_pk((f32x2){v1[0], v1[1]}), d = gelu_pk((f32x2){v1[2], v1[3]});
                        v0 = (f32x4){a.x, a.y, b.x, b.y}; v1 = (f32x4){c.x, c.y, d.x, d.y}; }
                    v0 = v0 * sc; v1 = v1 * sc; u32x4 w; w.x = cvt_pk_bf16(v0[0], v0[1]); w.y = cvt_pk_bf16(v0[2], v0[3]); w.z = cvt_pk_bf16(v1[0], v1[1]); w.w = cvt_pk_bf16(v1[2], v1[3]);
                    *(u32x4*)(rowp + bj * HALF) = w; } }
    }
};

struct EpiResGate {
    static constexpr bool PERM = false, AFTER_DRAIN = false;
    const float* base_lat; const float* base_ctx;
    float* out; const float* gate;
    __device__ __forceinline__ void operator()(const f32x4 (&acc)[2][2][4][2], const Unit& u, int wr, int wc, int fr, int fq) const {
        const int row0 = u.pm * BM + wr * 64 + fr, col0 = u.pn * BM + wc * 32 + 4 * fq;
        const int v = u.pm < 64 ? (u.pm >> 3) : 8;
        const float* gp = gate + (size_t)v * 12288 + col0;
        const float* base = u.pm < 64 ? base_lat : base_ctx;
        f32x4 gv[2][2];
#pragma unroll
        for (int bj = 0; bj < 2; ++bj)
#pragma unroll
            for (int n = 0; n < 2; ++n) gv[bj][n] = *(const f32x4*)(gp + bj * HALF + n * 16);
#pragma unroll
        for (int ai = 0; ai < 2; ++ai)
#pragma unroll
            for (int m = 0; m < 4; ++m) { const size_t off = (size_t)(row0 + ai * HALF + m * 16) * 2048 + col0;
#pragma unroll
                for (int bj = 0; bj < 2; ++bj)
#pragma unroll
                    for (int n = 0; n < 2; ++n) { const f32x4 b = *(const f32x4*)(base + off + bj * HALF + n * 16);
                        *(f32x4*)(out + off + bj * HALF + n * 16) = b + gv[bj][n] * acc[ai][bj][m][n]; } }
    }
};

struct EpiResGateB16 {
    static constexpr bool PERM = true, AFTER_DRAIN = false;
    const float* base32_lat; const float* base32_ctx;
    const bf16_t* base16; bf16_t* out; const float* gate;
    __device__ __forceinline__ void operator()(const f32x4 (&acc)[2][2][4][2], const Unit& u, int wr, int wc, int fr, int fq) const {
        const int row0 = u.pm * BM + wr * 64 + fr, col0 = u.pn * BM + wc * 32 + 8 * fq;
        const int v = u.pm < 64 ? (u.pm >> 3) : 8;
        const float* gp = gate + (size_t)v * 12288 + col0;
        const float* b32 = u.pm < 64 ? base32_lat : base32_ctx;
        f32x4 gv[2][2];
#pragma unroll
        for (int bj = 0; bj < 2; ++bj)
#pragma unroll
            for (int n = 0; n < 2; ++n) gv[bj][n] = *(const f32x4*)(gp + bj * HALF + 4 * n);
#pragma unroll
        for (int ai = 0; ai < 2; ++ai)
#pragma unroll
            for (int m = 0; m < 4; ++m) { const size_t off = (size_t)(row0 + ai * HALF + m * 16) * 2048 + col0;
#pragma unroll
                for (int bj = 0; bj < 2; ++bj) {
                    f32x4 b0, b1;
                    if (b32) { b0 = *(const f32x4*)(b32 + off + bj * HALF); b1 = *(const f32x4*)(b32 + off + bj * HALF + 4); }
                    else { const u32x4 w = *(const u32x4*)(base16 + off + bj * HALF);
                        b0 = (f32x4){__builtin_bit_cast(float, w.x << 16), __builtin_bit_cast(float, w.x & 0xffff0000u), __builtin_bit_cast(float, w.y << 16), __builtin_bit_cast(float, w.y & 0xffff0000u)};
                        b1 = (f32x4){__builtin_bit_cast(float, w.z << 16), __builtin_bit_cast(float, w.z & 0xffff0000u), __builtin_bit_cast(float, w.w << 16), __builtin_bit_cast(float, w.w & 0xffff0000u)}; }
                    const f32x4 v0 = b0 + gv[bj][0] * acc[ai][bj][m][0], v1 = b1 + gv[bj][1] * acc[ai][bj][m][1];
                    u32x4 o; o.x = cvt_pk_bf16(v0[0], v0[1]); o.y = cvt_pk_bf16(v0[2], v0[3]); o.z = cvt_pk_bf16(v1[0], v1[1]); o.w = cvt_pk_bf16(v1[2], v1[3]);
                    *(u32x4*)(out + off + bj * HALF) = o; } }
    }
};
struct EpiInSplit {
    static constexpr bool PERM = true, AFTER_DRAIN = false;
    bf16_t* Z; int ldz; bf16_t* QH; bf16_t* KH; bf16_t* VH;
    __device__ __forceinline__ void operator()(const f32x4 (&acc)[2][2][4][2], const Unit& u, int wr, int wc, int fr, int fq) const {
        const int row0 = u.pm * BM + wr * 64 + fr, colt = u.pn * BM, blk = colt >> 10;
        const bool hm = blk >= 1 && blk <= 3;
        bf16_t* dst = blk == 1 ? QH : (blk == 2 ? KH : (blk == 3 ? VH : Z));
        const __amdgpu_buffer_rsrc_t rs = __builtin_amdgcn_make_buffer_rsrc(dst, 0, 0x7fffffff, 0x00020000);
        const unsigned lane_hm = ((unsigned)(((colt & 1023) >> 6) + (wc >> 1)) * 2048u * 64u + (unsigned)((wc & 1) * 32 + 8 * fq)) * 2u, step_hm = 2u * 2048u * 64u * 2u;
        const unsigned lane_rm = (unsigned)(colt + wc * 32 + 8 * fq) * 2u, step_rm = (unsigned)HALF * 2u;
        const unsigned lane_off = hm ? lane_hm : lane_rm, step = hm ? step_hm : step_rm;
#pragma unroll
        for (int ai = 0; ai < 2; ++ai)
#pragma unroll
            for (int m = 0; m < 4; ++m) { const unsigned row = (unsigned)(row0 + ai * HALF + m * 16);
                const unsigned rowb = hm ? ((row >> 11) * 16u * 2048u + (row & 2047u)) * 128u : row * (unsigned)ldz * 2u;
#pragma unroll
                for (int bj = 0; bj < 2; ++bj) { const f32x4 v0 = acc[ai][bj][m][0], v1 = acc[ai][bj][m][1];
                    u32x4 w; w.x = cvt_pk_bf16(v0[0], v0[1]); w.y = cvt_pk_bf16(v0[2], v0[3]); w.z = cvt_pk_bf16(v1[0], v1[1]); w.w = cvt_pk_bf16(v1[2], v1[3]);
                    __builtin_amdgcn_raw_buffer_store_b128(w, rs, (int)(rowb + lane_off + (unsigned)bj * step), 0, 0); } }
    }
};

template <class Epi, class Sched, bool ALIGN_EPI = false, bool SP2 = false>
__device__ __forceinline__ void gemm_phase(PG8_LAS unsigned char* lds, const Gemm g, const Sched& S, const Epi& E, int tid_in) {
    int tid_ = tid_in; asm volatile("" : "+v"(tid_));
    const int tid = tid_, wid = __builtin_amdgcn_readfirstlane(tid >> 6), lane = tid & 63, wr = wid >> 2, wc = wid & 3, fr = lane & 15, fq = lane >> 4;
    const int K = g.K, nt = K / BK;
    unsigned voffA[2], voffB[2];
#pragma unroll
    for (int i = 0; i < 2; ++i) { int R, C; stage_rc(tid * 16 + i * 8192, R, C); const int Rb = Epi::PERM ? ((R & ~31) + perm32(R & 31)) : R;
        voffA[i] = (unsigned)(R * K + C) * 2u; voffB[i] = (unsigned)(Rb * K + C) * 2u; }
    const size_t kstep = (size_t)(BK * 2);
    const size_t hstep = (size_t)HALF * K * 2;
    const size_t tstep = 2 * hstep;
    const unsigned ldsw = (unsigned)wid * 1024u;
    const int aoff = lds_byte(wr * 64 + fr, fq * 8), boff = lds_byte(wc * 32 + fr, fq * 8);
#define PG8_SA(b, h) (((b) * 2 + (h)) * HTB)
#define PG8_SB(b, h) ((4 + (b) * 2 + (h)) * HTB)
#define PG8_STAGE(bufoff, gbase, voff) do { _Pragma("unroll") for (int _i = 0; _i < 2; ++_i) \
        __builtin_amdgcn_global_load_lds((const unsigned*)((const char*)(gbase) + (voff)[_i]), (PG8_LAS unsigned*)(lds + (bufoff) + ldsw + _i * 8192), 16, 0, 0); } while (0)
#define PG8_LDA(dst, b, h) do { _Pragma("unroll") for (int m = 0; m < 4; ++m) _Pragma("unroll") for (int k = 0; k < 2; ++k) dst[m][k] = *(const PG8_LAS bf16x8*)(lds + PG8_SA(b, h) + aoff + m * 2048 + k * 1024); } while (0)
#define PG8_LDB(dst, b, h) do { _Pragma("unroll") for (int n = 0; n < 2; ++n) _Pragma("unroll") for (int k = 0; k < 2; ++k) dst[n][k] = *(const PG8_LAS bf16x8*)(lds + PG8_SB(b, h) + boff + n * 2048 + k * 1024); } while (0)
#define PG8_MMA(ai, bj, At, Bt) do { __builtin_amdgcn_s_setprio(1); _Pragma("unroll") for (int m = 0; m < 4; ++m) _Pragma("unroll") for (int n = 0; n < 2; ++n) _Pragma("unroll") for (int k = 0; k < 2; ++k) \
        acc[ai][bj][m][n] = __builtin_amdgcn_mfma_f32_16x16x32_bf16(Bt[n][k], At[m][k], acc[ai][bj][m][n], 0, 0, 0); __builtin_amdgcn_s_setprio(0); } while (0)
#define PG8_WAIT_V(n) asm volatile("s_waitcnt vmcnt(" #n ")" ::: "memory")
#define PG8_WAIT_L(n) asm volatile("s_waitcnt lgkmcnt(" #n ")" ::: "memory")
#define PG8_BAR __builtin_amdgcn_s_barrier()
#define PG8_SCHED __builtin_amdgcn_sched_barrier(0)
    Unit cur, nxt; int ui = 0;
    if (!S.next(0, cur)) return;
    f32x4 acc[2][2][4][2];
#pragma unroll
    for (int a = 0; a < 2; ++a)
#pragma unroll
        for (int b = 0; b < 2; ++b)
#pragma unroll
            for (int m = 0; m < 4; ++m)
#pragma unroll
                for (int n = 0; n < 2; ++n) acc[a][b][m][n] = (f32x4){0.f, 0.f, 0.f, 0.f};
    bf16x8 At[4][2], B0[2][2], B1[2][2];
    const char* cA = (const char*)g.A + (size_t)cur.pm * tstep; const char* cB = (const char*)g.Bt + (size_t)cur.pn * tstep;
    S.a_ready(cur);
    if constexpr (SP2) {
        PG8_STAGE(PG8_SB(0, 0), cB, voffB); PG8_STAGE(PG8_SB(0, 1), cB + hstep, voffB); PG8_STAGE(PG8_SA(0, 0), cA, voffA); PG8_STAGE(PG8_SA(0, 1), cA + hstep, voffA);
        if (wr == 1) PG8_BAR;
        PG8_WAIT_V(2); PG8_BAR;
        PG8_STAGE(PG8_SB(1, 0), cB + kstep, voffB); PG8_STAGE(PG8_SA(1, 0), cA + kstep, voffA); PG8_STAGE(PG8_SB(1, 1), cB + hstep + kstep, voffB);
        PG8_WAIT_V(6); PG8_BAR;
    } else {
        PG8_STAGE(PG8_SB(0, 0), cB, voffB); PG8_STAGE(PG8_SA(0, 0), cA, voffA); PG8_STAGE(PG8_SB(0, 1), cB + hstep, voffB); PG8_STAGE(PG8_SA(0, 1), cA + hstep, voffA);
        if (wr == 1) PG8_BAR;
        PG8_WAIT_V(4); PG8_BAR;
        PG8_STAGE(PG8_SB(1, 0), cB + kstep, voffB); PG8_STAGE(PG8_SA(1, 0), cA + kstep, voffA); PG8_STAGE(PG8_SB(1, 1), cB + hstep + kstep, voffB);
        PG8_WAIT_V(6); PG8_BAR;
    }
    for (;;) {
        const bool has_next = S.next(ui + 1, nxt);
        const char* nA = has_next ? (const char*)g.A + (size_t)nxt.pm * tstep : cA; const char* nB = has_next ? (const char*)g.Bt + (size_t)nxt.pn * tstep : cB;
        for (int t = 0; t < nt; t += 2) {
            const bool last = (t == nt - 2);
            const char* a1 = cA + (size_t)(t + 1) * kstep;
            const char* a2 = last ? nA : cA + (size_t)(t + 2) * kstep; const char* b2 = last ? nB : cB + (size_t)(t + 2) * kstep;
            const char* a3 = a2 + kstep; const char* b3 = b2 + kstep;
            if (last && has_next) S.a_ready(nxt);
            if constexpr (SP2) {
            PG8_LDB(B0, 0, 0); PG8_LDB(B1, 0, 1); PG8_SCHED; PG8_LDA(At, 0, 0); PG8_STAGE(PG8_SA(1, 1), a1 + hstep, voffA);
            PG8_WAIT_V(8); PG8_WAIT_L(0); PG8_BAR; PG8_MMA(0, 0, At, B0); PG8_MMA(0, 1, At, B1); PG8_BAR; PG8_SCHED;
            PG8_LDA(At, 0, 1); PG8_STAGE(PG8_SB(0, 0), b2, voffB); PG8_STAGE(PG8_SB(0, 1), b2 + hstep, voffB); PG8_STAGE(PG8_SA(0, 0), a2, voffA);
            PG8_WAIT_V(8); PG8_WAIT_L(0); PG8_BAR; PG8_MMA(1, 0, At, B0); PG8_MMA(1, 1, At, B1); PG8_BAR; PG8_SCHED;
            PG8_LDB(B0, 1, 0); PG8_LDB(B1, 1, 1); PG8_SCHED; PG8_LDA(At, 1, 0); PG8_STAGE(PG8_SA(0, 1), a2 + hstep, voffA);
            PG8_WAIT_V(8); PG8_WAIT_L(0); PG8_BAR; PG8_MMA(0, 0, At, B0); PG8_MMA(0, 1, At, B1); PG8_BAR; PG8_SCHED;
            PG8_LDA(At, 1, 1); PG8_STAGE(PG8_SB(1, 0), b3, voffB); PG8_STAGE(PG8_SB(1, 1), b3 + hstep, voffB); PG8_STAGE(PG8_SA(1, 0), a3, voffA);
            PG8_WAIT_V(8); PG8_WAIT_L(0); PG8_BAR; PG8_MMA(1, 0, At, B0); PG8_MMA(1, 1, At, B1); PG8_BAR; PG8_SCHED;
            } else {
            PG8_LDB(B0, 0, 0); PG8_SCHED; PG8_LDA(At, 0, 0); PG8_STAGE(PG8_SA(1, 1), a1 + hstep, voffA);
            PG8_WAIT_L(8); PG8_BAR; PG8_WAIT_L(0); PG8_MMA(0, 0, At, B0); PG8_BAR; PG8_SCHED;
            PG8_LDB(B1, 0, 1); PG8_STAGE(PG8_SB(0, 0), b2, voffB);
            PG8_BAR; PG8_WAIT_L(0); PG8_MMA(0, 1, At, B1); PG8_BAR;
            PG8_LDA(At, 0, 1); PG8_STAGE(PG8_SA(0, 0), a2, voffA);
            PG8_BAR; PG8_WAIT_L(0); PG8_MMA(1, 0, At, B0); PG8_BAR; PG8_SCHED;
            PG8_STAGE(PG8_SB(0, 1), b2 + hstep, voffB);
            PG8_WAIT_V(6); PG8_BAR; PG8_MMA(1, 1, At, B1); PG8_BAR;
            PG8_LDB(B0, 1, 0); PG8_SCHED; PG8_LDA(At, 1, 0); PG8_STAGE(PG8_SA(0, 1), a2 + hstep, voffA);
            PG8_WAIT_L(8); PG8_BAR; PG8_WAIT_L(0); PG8_MMA(0, 0, At, B0); PG8_BAR; PG8_SCHED;
            PG8_LDB(B1, 1, 1); PG8_STAGE(PG8_SB(1, 0), b3, voffB);
            PG8_BAR; PG8_WAIT_L(0); PG8_MMA(0, 1, At, B1); PG8_BAR;
            PG8_LDA(At, 1, 1); PG8_STAGE(PG8_SA(1, 0), a3, voffA);
            PG8_BAR; PG8_WAIT_L(0); PG8_MMA(1, 0, At, B0); PG8_BAR; PG8_SCHED;
            PG8_STAGE(PG8_SB(1, 1), b3 + hstep, voffB);
            PG8_WAIT_V(6); PG8_BAR; PG8_MMA(1, 1, At, B1); PG8_BAR;
            }
        }
        if constexpr (ALIGN_EPI) { if (wr == 0) PG8_BAR; }
        if constexpr (!Epi::AFTER_DRAIN) { E(acc, cur, wr, wc, fr, fq); S.done(cur); }
        if (!has_next) break;
#pragma unroll
        for (int a = 0; a < 2; ++a)
#pragma unroll
            for (int b = 0; b < 2; ++b)
#pragma unroll
                for (int m = 0; m < 4; ++m)
#pragma unroll
                    for (int n = 0; n < 2; ++n) acc[a][b][m][n] = (f32x4){0.f, 0.f, 0.f, 0.f};
        cur = nxt; cA = nA; cB = nB; ++ui;
        if constexpr (ALIGN_EPI) { if (wr == 1) PG8_BAR; }
    }
    PG8_WAIT_V(0);
    if constexpr (!ALIGN_EPI) { if (wr == 0) PG8_BAR; }
    PG8_BAR;
    if constexpr (Epi::AFTER_DRAIN) { E.fused(acc, cur, wr, wc, fr, fq, lds, wid, lane); S.done(cur); }
#undef PG8_SA
#undef PG8_SB
#undef PG8_STAGE
#undef PG8_LDA
#undef PG8_LDB
#undef PG8_MMA
#undef PG8_WAIT_V
#undef PG8_WAIT_L
#undef PG8_BAR
#undef PG8_SCHED
}
}

constexpr int NWAVES = 8, NTHREADS = 512;
constexpr int NB = 8, SEQ = 2048, DM = 2048, DEPTH = 4, CTXL = 256;
constexpr int MLAT = NB * SEQ, MCTX = NB * CTXL, MALL = MLAT + MCTX;
constexpr int PW = 5120, FH = 5504, FU = 2 * FH, NH = 16, MODW = 6 * DM;
constexpr int ZC_AX = 0, ZC_AY = 512, ZC_Q = 1024, ZC_K = 2048, ZC_V = 3072, ZC_SU = 4096, ZC_SV = 4608;
constexpr float NORM_EPS = 1e-6f;
constexpr int NCHUNK = MALL / 64;

constexpr size_t MiB = 1u << 20;
constexpr size_t WS_CTL = 0, CTL_ZERO_BYTES = 1 * MiB;
constexpr size_t WS_MOD = 1 * MiB;
constexpr size_t WS_GWT = 3 * MiB;
constexpr size_t WS_SWB = 4 * MiB;
constexpr size_t WS_AGG = 5 * MiB;
constexpr size_t WS_ROPE = 7 * MiB + 512 * 1024;
constexpr size_t WS_AGT = 1288 * MiB;
constexpr size_t WS_WT = 8 * MiB;
constexpr size_t WT_IN = 0, WT_OUT = (size_t)PW * DM * 2, WT_UP = WT_OUT + (size_t)DM * DM * 2, WT_DN = WT_UP + (size_t)FU * DM * 2, WT_LAYER = WT_DN + (size_t)DM * FH * 2;
static_assert(WT_LAYER == 96993280, "weights per layer");
constexpr size_t WS_X = 378 * MiB;
constexpr size_t WS_HX = 522 * MiB;
constexpr size_t WS_ACT = 594 * MiB;
constexpr size_t WS_R1 = 788 * MiB;
constexpr size_t WS_Z = WS_R1;
constexpr size_t WS_MIX = WS_R1 + 180 * MiB;
constexpr size_t WS_AB = WS_R1 + 252 * MiB;
constexpr size_t WS_U = WS_R1;
constexpr size_t WS_QR = 1184 * MiB, WS_KR = 1216 * MiB, WS_VT = 1248 * MiB, WS_KC = 1280 * MiB, WS_VTC = 1284 * MiB, WS_END = 1298 * MiB;
static_assert(WS_WT + 4 * WT_LAYER <= WS_X && WS_ACT + (size_t)MALL * FH * 2 <= WS_R1 && WS_U + (size_t)MALL * FU * 2 <= WS_QR && WS_AB + (size_t)4 * MALL * 512 * 4 <= WS_QR, "d_ws map");
constexpr int CW_BAR = 4096;
constexpr int CW_Q = 8192;

constexpr int RING_BYTES = 131072;
constexpr int MISC_OFF = 144 * 1024 - 128;
constexpr int PTR_OFF = 144 * 1024 - 512;
constexpr int LDS_BYTES = 147456;

#define GAS __attribute__((address_space(1)))
#define LAS __attribute__((address_space(3)))
typedef unsigned short bf16;
typedef unsigned v4u __attribute__((ext_vector_type(4)));
typedef unsigned v2u __attribute__((ext_vector_type(2)));
typedef float f32x4 __attribute__((ext_vector_type(4)));
typedef short bf16x8 __attribute__((ext_vector_type(8)));
__device__ __forceinline__ unsigned f2bf(float f) { unsigned u = __builtin_bit_cast(unsigned, f); return (u + 0x7fffu + ((u >> 16) & 1u)) >> 16; }
typedef float f32x2_t __attribute__((ext_vector_type(2))); typedef __bf16 bf16x2_t __attribute__((ext_vector_type(2)));
__device__ __forceinline__ unsigned pk2(float lo, float hi) { f32x2_t v = {lo, hi}; bf16x2_t b = __builtin_convertvector(v, bf16x2_t); return __builtin_bit_cast(unsigned, b); }
__device__ __forceinline__ float bflo(unsigned w) { return __builtin_bit_cast(float, w << 16); }
__device__ __forceinline__ float bfhi(unsigned w) { return __builtin_bit_cast(float, w & 0xffff0000u); }
__device__ __forceinline__ float bf1(bf16 h) { return __builtin_bit_cast(float, (unsigned)h << 16); }
__device__ __forceinline__ void unpack8(v4u w, float (&x)[8]) { x[0] = bflo(w.x); x[1] = bfhi(w.x); x[2] = bflo(w.y); x[3] = bfhi(w.y); x[4] = bflo(w.z); x[5] = bfhi(w.z); x[6] = bflo(w.w); x[7] = bfhi(w.w); }
__device__ __forceinline__ v4u pack8(const float (&x)[8]) { v4u w; w.x = pk2(x[0], x[1]); w.y = pk2(x[2], x[3]); w.z = pk2(x[4], x[5]); w.w = pk2(x[6], x[7]); return w; }
__device__ __forceinline__ float sigm(float x) { return __builtin_amdgcn_rcpf(1.f + __expf(-x)); }
__device__ __forceinline__ float silu_f(float x) { return x * __builtin_amdgcn_rcpf(1.f + __expf(-x)); }
__device__ __forceinline__ float gelu_t(float x) { const float u = 0.7978845608028654f * (x + 0.044715f * x * x * x); return x * __builtin_amdgcn_rcpf(1.f + __expf(-2.f * u)); }
__device__ __forceinline__ float shx(float v, int mask, int lane) { return __builtin_bit_cast(float, __builtin_amdgcn_ds_bpermute((lane ^ mask) << 2, __builtin_bit_cast(int, v))); }
__device__ __forceinline__ unsigned shxu(unsigned v, int mask, int lane) { return (unsigned)__builtin_amdgcn_ds_bpermute((lane ^ mask) << 2, (int)v); }
__device__ __forceinline__ float wave_sum(float v, int lane) {
#pragma unroll
    for (int o = 1; o < 64; o <<= 1) v += shx(v, o, lane);
    return v;
}
#define LDS_WAIT() asm volatile("s_waitcnt lgkmcnt(0)" ::: "memory")
__device__ __forceinline__ f32x4 mfma16(bf16x8 a, bf16x8 b, f32x4 c) { return __builtin_amdgcn_mfma_f32_16x16x32_bf16(a, b, c, 0, 0, 0); }
__device__ __forceinline__ bf16x8 ldfrag(const bf16* p) { return *(const bf16x8*)p; }
#define XB_TMO      128
#define XB_XCNT(j)  (256  + 64 * (j))
#define XB_XSUB(j)  (1280 + 64 * (j))
#define XB_XGEN(j)  (2304 + 64 * (j))
#define XB_TOP      3328
#define XB_TOPGEN   3392
#define XCD_BAR_WORDS 3456
#define XB_SPIN_CAP (1u << 18)

__device__ __forceinline__ unsigned xb_ld(unsigned* p)              { return __hip_atomic_load(p, __ATOMIC_RELAXED, __HIP_MEMORY_SCOPE_AGENT); }
__device__ __forceinline__ unsigned xb_add(unsigned* p, unsigned v) { return __hip_atomic_fetch_add(p, v, __ATOMIC_RELAXED, __HIP_MEMORY_SCOPE_AGENT); }
__device__ __forceinline__ unsigned xb_xcc_id() { return (unsigned)__builtin_amdgcn_s_getreg((3 << 11) | 20) & 0xFu; }
#define XB_SPIN(cond, bar) do { unsigned _sp = 0; while (cond) { __builtin_amdgcn_s_sleep(1); \
    if ((++_sp & 255u) == 0u) { if (xb_ld(&(bar)[XB_TMO])) break; if (_sp > XB_SPIN_CAP) { atomicAdd(&(bar)[XB_TMO], 1u); break; } } } } while (0)

struct XcdBarrier {
    unsigned* bar; unsigned x;
    volatile LAS unsigned* st;
};

__device__ __forceinline__ XcdBarrier xcd_barrier_post(unsigned* bar, volatile LAS unsigned* st) {
    XcdBarrier b; b.bar = bar; b.x = xb_xcc_id(); b.st = st;
    if (threadIdx.x == 0) (void)xb_add(&bar[XB_XCNT(b.x)], 1u);
    return b;
}
__device__ __forceinline__ void xcd_barrier_complete(unsigned* bar, unsigned x, unsigned& nloc, unsigned& nx) {
    const unsigned G = gridDim.x * gridDim.y * gridDim.z;
    unsigned sum, cnt, mine, sp = 0u;
    for (;;) {
        sum = 0u; cnt = 0u; mine = 0u;
#pragma unroll
        for (unsigned j = 0; j < 16; ++j) { const unsigned c = xb_ld(&bar[XB_XCNT(j)]); sum += c; cnt += (c > 0u) ? 1u : 0u; mine = (j == x) ? c : mine; }
        if (sum == G) break;
        __builtin_amdgcn_s_sleep(1);
        if ((++sp & 255u) == 0u) { if (xb_ld(&bar[XB_TMO])) break; if (sp > XB_SPIN_CAP) { atomicAdd(&bar[XB_TMO], 1u); break; } }
    }
    nloc = mine > 0u ? mine : 1u; nx = cnt > 0u ? cnt : 1u;
}

__device__ __forceinline__ void xcd_barrier(const XcdBarrier& b, int tid  ) {
    asm volatile("s_waitcnt vmcnt(0)" ::: "memory");
    __syncthreads();
    if (tid == 0) {
        unsigned* bar = b.bar;
        __builtin_amdgcn_s_waitcnt(0);
        unsigned nloc = b.st[0], nx = b.st[1];
        if (nloc == 0u) { xcd_barrier_complete(bar, b.x, nloc, nx); b.st[0] = nloc; b.st[1] = nx; }
        const unsigned old = xb_add(&bar[XB_XSUB(b.x)], 1u);
        const unsigned gen = old / nloc;
        if (old + 1u == (gen + 1u) * nloc) {
            __builtin_amdgcn_fence(__ATOMIC_RELEASE, "agent");
            asm volatile("s_waitcnt vmcnt(0)" ::: "memory");
            const unsigned og = xb_add(&bar[XB_TOP], 1u);
            const unsigned tg = og / nx;
            if (og + 1u == (tg + 1u) * nx) xb_add(&bar[XB_TOPGEN], 1u);
            else XB_SPIN(xb_ld(&bar[XB_TOPGEN]) == tg, bar);
            __builtin_amdgcn_fence(__ATOMIC_ACQUIRE, "agent");
            xb_add(&bar[XB_XGEN(b.x)], 1u);
            asm volatile("s_waitcnt vmcnt(0)" ::: "memory");
        } else {
            XB_SPIN(xb_ld(&bar[XB_XGEN(b.x)]) == gen, bar);
            __builtin_amdgcn_fence(__ATOMIC_ACQUIRE, "agent");
            asm volatile("s_waitcnt vmcnt(0)" ::: "memory");
        }
    }
    __syncthreads();
}

struct Args { const float* in[25]; float* out; unsigned char* ws; int ph_lo, ph_hi; };
enum { I_X = 0, I_C, I_CTX, I_CCTX, I_WADA, I_BADA, I_NMG, I_NFG, I_WIN, I_LCW, I_LCB, I_LGW, I_LGB, I_LLAM, I_RPB, I_SLG, I_SLB, I_SW, I_SB, I_WOUT, I_FUP, I_FCW, I_FCB, I_FDN, I_FNG };
struct Frame {
    LAS unsigned char* lds;
    int tid, lane, wave, G, bid;
    unsigned char* ws; float* out;
    __device__ __forceinline__ const float* inp(int i) const { const unsigned long long v = *(const LAS unsigned long long*)(lds + PTR_OFF + 8 * i);
        return (const float*)(const GAS float*)(((unsigned long long)(unsigned)__builtin_amdgcn_readfirstlane((int)(v >> 32)) << 32) | (unsigned long long)(unsigned)__builtin_amdgcn_readfirstlane((int)(unsigned)v)); }
    __device__ __forceinline__ float* MOD() const { return (float*)(ws + WS_MOD); }
    __device__ __forceinline__ bf16* GWT() const { return (bf16*)(ws + WS_GWT); }
    __device__ __forceinline__ bf16* SWB() const { return (bf16*)(ws + WS_SWB); }
    __device__ __forceinline__ float* AGG() const { return (float*)(ws + WS_AGG); }
    __device__ __forceinline__ float* AGT() const { return (float*)(ws + WS_AGT); }
    __device__ __forceinline__ float* ROPE() const { return (float*)(ws + WS_ROPE); }
    __device__ __forceinline__ float* C8() const { return (float*)(ws + WS_ROPE + 16384); }
    __device__ __forceinline__ bf16* X() const { return (bf16*)(ws + WS_X); }
    __device__ __forceinline__ bf16* HX() const { return (bf16*)(ws + WS_HX); }
    __device__ __forceinline__ bf16* ACT() const { return (bf16*)(ws + WS_ACT); }
    __device__ __forceinline__ bf16* Z() const { return (bf16*)(ws + WS_Z); }
    __device__ __forceinline__ bf16* MIX() const { return (bf16*)(ws + WS_MIX); }
    __device__ __forceinline__ unsigned* AB2() const { return (unsigned*)(ws + WS_AB); }
    __device__ __forceinline__ bf16* U() const { return (bf16*)(ws + WS_U); }
    __device__ __forceinline__ bf16* QR() const { return (bf16*)(ws + WS_QR); }
    __device__ __forceinline__ bf16* KR() const { return (bf16*)(ws + WS_KR); }
    __device__ __forceinline__ bf16* VT() const { return (bf16*)(ws + WS_VT); }
    __device__ __forceinline__ bf16* KC() const { return (bf16*)(ws + WS_KC); }
    __device__ __forceinline__ bf16* VTC() const { return (bf16*)(ws + WS_VTC); }
};

__device__ __forceinline__ void p0_transpose_item(const float* W, int K, int N, bf16* WT, LAS float* scr, int item, int lane) {
    const int nblk = N / 32, kb = item / nblk, nb = item % nblk, k0 = 64 * kb, n0 = 32 * nb;
#pragma unroll 8
    for (int i = 0; i < 32; ++i) { const int kk = 2 * i + (lane >> 5); scr[kk * 33 + (lane & 31)] = W[(size_t)(k0 + kk) * N + n0 + (lane & 31)]; }
    LDS_WAIT(); asm volatile("" ::: "memory");
    const int c = lane & 7;
#pragma unroll
    for (int j = 0; j < 4; ++j) { const int n = (lane >> 3) + 8 * j; const LAS float* s = scr + (8 * c) * 33 + n;
        v4u o; o.x = pk2(s[0 * 33], s[1 * 33]); o.y = pk2(s[2 * 33], s[3 * 33]); o.z = pk2(s[4 * 33], s[5 * 33]); o.w = pk2(s[6 * 33], s[7 * 33]);
        *(v4u*)(WT + (size_t)(n0 + n) * K + k0 + 8 * c) = o; }
    LDS_WAIT(); asm volatile("" ::: "memory");
}
__device__ __forceinline__ void p0_adaln_unit(Frame& F, int L, int cb) {
    LAS float* sc = (LAS float*)F.lds;
    const float* c = F.inp(I_C); const float* cc = F.inp(I_CCTX);
    for (int i = F.tid; i < 9 * 2048; i += NTHREADS) { const int v = i >> 11, k = i & 2047; const float x = v < 8 ? c[v * 2048 + k] : cc[k]; sc[k * 12 + v] = silu_f(x); }
    __syncthreads();
    const float* W = F.inp(I_WADA) + (size_t)L * DM * MODW + cb * 256 + 4 * F.lane;
    f32x4 acc[9];
#pragma unroll
    for (int v = 0; v < 9; ++v) acc[v] = (f32x4){0.f, 0.f, 0.f, 0.f};
    const int kbeg = F.wave * 256;
    for (int k = kbeg; k < kbeg + 256; k += 8) {
        f32x4 w[8];
#pragma unroll
        for (int q = 0; q < 8; ++q) w[q] = *(const f32x4*)(W + (size_t)(k + q) * MODW);
#pragma unroll
        for (int q = 0; q < 8; ++q) {
            const f32x4 s0 = *(const LAS f32x4*)(sc + (k + q) * 12), s1 = *(const LAS f32x4*)(sc + (k + q) * 12 + 4); const float s8 = sc[(k + q) * 12 + 8];
            acc[0] += w[q] * s0.x; acc[1] += w[q] * s0.y; acc[2] += w[q] * s0.z; acc[3] += w[q] * s0.w;
            acc[4] += w[q] * s1.x; acc[5] += w[q] * s1.y; acc[6] += w[q] * s1.z; acc[7] += w[q] * s1.w; acc[8] += w[q] * s8;
        }
    }
    __syncthreads();
    LAS float* red = (LAS float*)F.lds;
#pragma unroll
    for (int v = 0; v < 9; ++v) *(LAS f32x4*)(red + (F.wave * 9 + v) * 256 + 4 * F.lane) = acc[v];
    __syncthreads();
    const float* bias = F.inp(I_BADA) + (size_t)L * MODW + cb * 256;
    for (int o = F.tid; o < 9 * 256; o += NTHREADS) { const int v = o >> 8, col = o & 255; float s = bias[col];
#pragma unroll
        for (int w = 0; w < 8; ++w) s += red[(w * 9 + v) * 256 + col];
        F.MOD()[((size_t)L * 9 + v) * MODW + cb * 256 + col] = s; }
    __syncthreads();
}
__device__ __forceinline__ void convert_layer(Frame& F, int L, int cu0, int ncu) {
    if (F.bid < cu0 || F.bid >= cu0 + ncu) return;
    LAS float* scr = (LAS float*)(F.lds + F.wave * 16384);
    const int gw = (F.bid - cu0) * NWAVES + F.wave, NGW = ncu * NWAVES;
    bf16* wt = (bf16*)(F.ws + WS_WT + (size_t)L * WT_LAYER);
    const float* w_in = F.inp(I_WIN) + (size_t)L * DM * PW; const float* w_out = F.inp(I_WOUT) + (size_t)L * DM * DM;
    const float* w_up = F.inp(I_FUP) + (size_t)L * DM * FU; const float* w_dn = F.inp(I_FDN) + (size_t)L * FH * DM;
    for (int it = gw; it < (DM / 64) * (PW / 32); it += NGW) p0_transpose_item(w_in, DM, PW, (bf16*)((char*)wt + WT_IN), scr, it, F.lane);
    for (int it = gw; it < (DM / 64) * (DM / 32); it += NGW) p0_transpose_item(w_out, DM, DM, (bf16*)((char*)wt + WT_OUT), scr, it, F.lane);
    for (int it = gw; it < (DM / 64) * (FU / 32); it += NGW) p0_transpose_item(w_up, DM, FU, (bf16*)((char*)wt + WT_UP), scr, it, F.lane);
    for (int it = gw; it < (FH / 64) * (DM / 32); it += NGW) p0_transpose_item(w_dn, FH, DM, (bf16*)((char*)wt + WT_DN), scr, it, F.lane);
}
__device__ __forceinline__ void p0_prologue(Frame& F) {
    for (int u = F.bid; u < DEPTH * 48; u += F.G) p0_adaln_unit(F, u / 48, u % 48);
    { const int gi = F.bid * NTHREADS + F.tid;
      if (gi < 1024) { const int pos = gi >> 4, f = gi & 15; double inv = 1.0; for (int i = 0; i < f; ++i) inv *= 0.5623413251903491;
          const float ang = (float)pos * (float)inv; double y = (double)ang; const double twopi = 6.283185307179586476925;
          const double kk = __builtin_rint(y / twopi); y -= kk * twopi; const double y2 = y * y;
          double cs = 1.0, sn = y, tc = 1.0, ts = y;
          for (int n = 1; n <= 16; ++n) { tc *= -y2 / (double)((2 * n - 1) * (2 * n)); ts *= -y2 / (double)((2 * n) * (2 * n + 1)); cs += tc; sn += ts; }
          F.ROPE()[gi * 2] = (float)cs; F.ROPE()[gi * 2 + 1] = (float)sn; } }
    { const int gi = F.bid * NTHREADS + F.tid, GN = F.G * NTHREADS; const float* gw = F.inp(I_LGW); const float* sw = F.inp(I_SW);
      for (int e = gi; e < DEPTH * 32 * 4096; e += GN) { const int m = e >> 12, o = (e >> 6) & 63, i = e & 63; F.GWT()[e] = (bf16)f2bf(gw[(size_t)m * 4096 + i * 64 + o]); }
      for (int e = gi; e < DEPTH * 8 * 16384; e += GN) F.SWB()[e] = (bf16)f2bf(sw[e]);
      const float* lam = F.inp(I_LLAM); for (int e = gi; e < DEPTH * 1024; e += GN) F.C8()[e] = -8.0f * log1pf(__expf(-lam[e])); }
    for (int L = 0; L < DEPTH; ++L) convert_layer(F, L, 0, F.G);
}

__device__ __forceinline__ void norm_rows(Frame& F, const float* src32, const bf16* src16, int row0, int nrows, const float* g, const float* sh, const float* sc) {
    f32x4 A[8], B[8];
#pragma unroll
    for (int j = 0; j < 8; ++j) { const int col = 4 * F.lane + 256 * j; const f32x4 gg = *(const f32x4*)(g + col), s = *(const f32x4*)(sc + col); A[j] = gg * (s + 1.0f); B[j] = *(const f32x4*)(sh + col); }
    for (int r = 0; r < nrows; ++r) {
        f32x4 v[8]; float s = 0.f;
        if (src32) { const f32x4* xr = (const f32x4*)(src32 + (size_t)(row0 + r) * DM) + F.lane;
#pragma unroll
            for (int j = 0; j < 8; ++j) v[j] = xr[64 * j]; }
        else { const v2u* xr = (const v2u*)(src16 + (size_t)(row0 + r) * DM) + F.lane;
#pragma unroll
            for (int j = 0; j < 8; ++j) { const v2u d = xr[64 * j]; v[j] = (f32x4){bflo(d.x), bfhi(d.x), bflo(d.y), bfhi(d.y)}; } }
#pragma unroll
        for (int j = 0; j < 8; ++j) s += (v[j].x * v[j].x + v[j].y * v[j].y) + (v[j].z * v[j].z + v[j].w * v[j].w);
        const float rstd = __builtin_amdgcn_rsqf(wave_sum(s, F.lane) * (1.0f / DM) + NORM_EPS);
        v2u* o = (v2u*)(F.HX() + (size_t)(row0 + r) * DM) + F.lane;
#pragma unroll
        for (int j = 0; j < 8; ++j) { const f32x4 y = v[j] * rstd * A[j] + B[j]; v2u w; w.x = pk2(y.x, y.y); w.y = pk2(y.z, y.w); o[64 * j] = w; }
    }
}
__device__ __forceinline__ void norm_range(Frame& F, int L, int which  , int r0, int r1) {
    if (r1 <= r0) return;
    const float* g = (which ? F.inp(I_NFG) : F.inp(I_NMG)) + (size_t)L * DM;
    const float* mod = F.MOD() + (size_t)L * 9 * MODW + (which ? 3 * DM : 0);
    const bool first = (L == 0 && which == 0);
    const int n = r1 - r0, per = (n + NWAVES - 1) / NWAVES; int a = r0 + F.wave * per, e = a + per < r1 ? a + per : r1;
    while (a < e) {
        const int v = a < MLAT ? (a >> 11) : 8; const int vend = a < MLAT ? ((a >> 11) + 1) << 11 : MALL; const int stop = e < vend ? e : vend;
        const float* m = mod + (size_t)v * MODW;
        const float* src32 = first ? (a < MLAT ? F.inp(I_X) : F.inp(I_CTX) - (size_t)MLAT * DM) : nullptr;
        norm_rows(F, src32, F.X(), a, stop - a, g, m, m + DM);
        a = stop;
    }
}
__device__ __forceinline__ void share(int rb, int re, int idx, int n, int& r0, int& r1) { const int per = (re - rb + n - 1) / n; r0 = rb + idx * per; r1 = r0 + per; if (r0 > re) r0 = re; if (r1 > re) r1 = re; }
__device__ __forceinline__ void final_norm_phase(Frame& F) {
    const int gw = F.bid * NWAVES + F.wave, NGW = F.G * NWAVES; const float* g = F.inp(I_FNG);
    f32x4 A[8];
#pragma unroll
    for (int j = 0; j < 8; ++j) A[j] = *(const f32x4*)(g + 4 * F.lane + 256 * j);
    for (int row = gw; row < MLAT; row += NGW) {
        const v2u* xr = (const v2u*)(F.X() + (size_t)row * DM) + F.lane; f32x4 v[8]; float s = 0.f;
#pragma unroll
        for (int j = 0; j < 8; ++j) { const v2u d = xr[64 * j]; v[j] = (f32x4){bflo(d.x), bfhi(d.x), bflo(d.y), bfhi(d.y)}; s += (v[j].x * v[j].x + v[j].y * v[j].y) + (v[j].z * v[j].z + v[j].w * v[j].w); }
        const float rstd = __builtin_amdgcn_rsqf(wave_sum(s, F.lane) * (1.0f / DM) + NORM_EPS);
        f32x4* o = (f32x4*)(F.out + (size_t)row * DM) + F.lane;
#pragma unroll
        for (int j = 0; j < 8; ++j) o[64 * j] = v[j] * rstd * A[j];
    }
}

__device__ __forceinline__ void convgate_phase(Frame& F, int L, int rbeg, int rend, int cu0, int ncu) {
    if (F.bid < cu0 || F.bid >= cu0 + ncu || rend <= rbeg) return;
    const int NRANGE = (ncu * NWAVES * 4) / 43;
    const int rlen = (rend - rbeg + NRANGE - 1) / NRANGE;
    const float* cw = F.inp(I_FCW) + (size_t)L * 3 * FU; const float* cbv = F.inp(I_FCB) + (size_t)L * FU;
    const bf16* U = F.U(); const v4u zero = (v4u){0u, 0u, 0u, 0u};
    for (int q = ((F.bid - cu0) * NWAVES + F.wave) * 4 + (F.lane >> 4); q < 43 * NRANGE; q += ncu * NWAVES * 4) {
        const int cb = q % 43, rg = q / 43, cl = F.lane & 15, j0 = cb * 128 + cl * 8;
        const int r_lo = rbeg + rg * rlen, r_hi = (r_lo + rlen < rend) ? r_lo + rlen : rend;
        float wa[3][8], wg[3][8], ba[8], bg[8];
#pragma unroll
        for (int k = 0; k < 3; ++k)
#pragma unroll
            for (int e = 0; e < 8; ++e) { wa[k][e] = cw[(size_t)k * FU + j0 + e]; wg[k][e] = cw[(size_t)k * FU + FH + j0 + e]; }
#pragma unroll
        for (int e = 0; e < 8; ++e) { ba[e] = cbv[j0 + e]; bg[e] = cbv[FH + j0 + e]; }
        v4u pA, pG, cA[4], cG[4], nA[4], nG[4];
#define CG_LD(r_, a_, g_) do { const int r__ = (r_); if (r__ >= rbeg && r__ < rend) { a_ = *(const v4u*)(U + (size_t)r__ * FU + j0); g_ = *(const v4u*)(U + (size_t)r__ * FU + FH + j0); } else { a_ = zero; g_ = zero; } } while (0)
        CG_LD(r_lo - 1, pA, pG);
#pragma unroll
        for (int i = 0; i < 4; ++i) CG_LD(r_lo + i, cA[i], cG[i]);
        for (int r = r_lo; r < r_hi; r += 4) {
#pragma unroll
            for (int i = 0; i < 4; ++i) CG_LD(r + 4 + i, nA[i], nG[i]);
#pragma unroll
            for (int i = 0; i < 4; ++i) {
                const int rr = r + i;
                if (rr < r_hi) {
                    const bool first = rr < MLAT ? (rr & 2047) == 0 : (rr & 255) == 0, last = rr < MLAT ? (rr & 2047) == 2047 : (rr & 255) == 255;
                    v4u la = (i == 0) ? pA : cA[(i + 3) & 3], lg = (i == 0) ? pG : cG[(i + 3) & 3], ra = (i == 3) ? nA[0] : cA[(i + 1) & 3], rgv = (i == 3) ? nG[0] : cG[(i + 1) & 3];
                    if (first) { la = zero; lg = zero; }
                    if (last) { ra = zero; rgv = zero; }
                    float xp[8], xc[8], xn[8], yp[8], yc[8], yn[8], o[8];
                    unpack8(la, xp); unpack8(cA[i], xc); unpack8(ra, xn); unpack8(lg, yp); unpack8(cG[i], yc); unpack8(rgv, yn);
#pragma unroll
                    for (int e = 0; e < 8; ++e) { const float a = ba[e] + wa[0][e] * xp[e] + wa[1][e] * xc[e] + wa[2][e] * xn[e]; const float g = bg[e] + wg[0][e] * yp[e] + wg[1][e] * yc[e] + wg[2][e] * yn[e]; o[e] = silu_f(g) * a; }
                    *(v4u*)(F.ACT() + (size_t)rr * FH + j0) = pack8(o);
                }
            }
            pA = cA[3]; pG = cG[3];
#pragma unroll
            for (int i = 0; i < 4; ++i) { cA[i] = nA[i]; cG[i] = nG[i]; }
        }
#undef CG_LD
    }
}

constexpr float AT_SC = 0.125f * 1.4426950408889634f;
__device__ __forceinline__ v4u rope_chunk(v4u own, int lane, bool is_x2, const float* cs  , float scale) {
    v4u par; par.x = shxu(own.x, 2, lane); par.y = shxu(own.y, 2, lane); par.z = shxu(own.z, 2, lane); par.w = shxu(own.w, 2, lane);
    float x[8], p[8], o[8]; unpack8(own, x); unpack8(par, p);
#pragma unroll
    for (int e = 0; e < 8; ++e) { const float c = cs[2 * e], s = cs[2 * e + 1]; o[e] = (is_x2 ? (x[e] * c + p[e] * s) : (x[e] * c - p[e] * s)) * scale; }
    return pack8(o);
}
__device__ __forceinline__ void prep_unit(Frame& F, bool ctx, int b, int h, int tt) {
    const int lane = F.lane, c = lane & 7;
    const int bh = b * NH + h;
    const size_t zrow0 = ctx ? (size_t)(MLAT + b * CTXL + 64 * tt) : (size_t)(b * SEQ + 64 * tt);
    const int half = c >> 2; const bool is_x2 = (c >> 1) & 1; const int f0 = 8 * (c & 1);
    struct PrepOps { v4u kq; f32x4 t4[4]; };
    PrepOps po[2];
#define PREP_LOAD(i_, o_) do { const int tl_ = 8 * (i_) + (lane >> 3); const bf16* zr_ = F.Z() + (zrow0 + tl_) * PW + 64 * h + 8 * c; \
        (o_).kq = ctx ? *(const v4u*)(zr_ + ZC_K) : *(const v4u*)(F.KR() + ((size_t)bh * SEQ + 64 * tt + tl_) * 64 + 8 * c);     \
        if (!ctx) { const int pos_ = half ? tl_ : tt; \
            _Pragma("unroll") for (int e = 0; e < 4; ++e) (o_).t4[e] = *(const f32x4*)(F.ROPE() + (pos_ * 16 + f0) * 2 + 4 * e); } } while (0)
    PREP_LOAD(0, po[0]);
#pragma unroll
    for (int i = 0; i < 8; ++i) {
        if (i + 1 < 8) PREP_LOAD(i + 1, po[(i + 1) & 1]);
        __builtin_amdgcn_sched_barrier(0);
        const PrepOps& o = po[i & 1];
        const int tl = 8 * i + (lane >> 3);
        if (!ctx) {
            float cs[16];
#pragma unroll
            for (int e = 0; e < 4; ++e) { cs[4 * e] = o.t4[e].x; cs[4 * e + 1] = o.t4[e].y; cs[4 * e + 2] = o.t4[e].z; cs[4 * e + 3] = o.t4[e].w; }
            const size_t off = ((size_t)bh * SEQ + 64 * tt + tl) * 64 + 8 * c;
            *(v4u*)(F.KR() + off) = rope_chunk(o.kq, lane, is_x2, cs, AT_SC);
        } else {
            float kx[8]; unpack8(o.kq, kx);
#pragma unroll
            for (int e = 0; e < 8; ++e) kx[e] *= AT_SC;
            *(v4u*)(F.KC() + ((size_t)bh * CTXL + 64 * tt + tl) * 64 + 8 * c) = pack8(kx);
        }
        __builtin_amdgcn_sched_barrier(0);
    }
#undef PREP_LOAD
}

constexpr int XC_ROW = 68;
__device__ __forceinline__ float one_minus_exp_neg(float x) {
    const float p = x * (1.0f + x * (-0.5f + x * (0.16666667f + x * (-0.041666668f + x * (0.0083333338f + x * -0.0013888889f)))));
    return x < 0.125f ? p : 1.0f - __expf(-x);
}
__device__ __forceinline__ void lru_ab_unit(Frame& F, int L, int u) {
    const int mc = u >> 2, q4 = u & 3;
    const int lane = F.lane, tt = F.wave >> 1, g = 2 * q4 + (F.wave & 1), tok = lane & 15, kg = lane >> 4;
    const int R0 = 64 * mc, R = R0 + 16 * tt + tok;
    const int seq_lo = mc < 256 ? (mc >> 5) * SEQ : MLAT + ((mc - 256) >> 2) * CTXL, seq_hi = seq_lo + (mc < 256 ? SEQ : CTXL);
    LAS float* xcs = (LAS float*)(F.lds + F.wave * (16 * XC_ROW * 4));
    const float* gb = F.inp(I_LGB) + (size_t)L * 4 * 512; const float* c8t = F.C8() + (size_t)L * 2 * 512;
    struct GateOps { bf16x8 wr0, wr1, wi0, wi1; f32x4 gbr, gbi, c8; };
    GateOps ops[2];
#define LRU_LOAD_OPS(it_, o_) do { const int d_ = (it_) >> 2, ot_ = (it_) & 3; \
        const bf16* wp_ = F.GWT() + ((((size_t)L * 2 + d_) * 2) * 8 + g) * 4096 + (16 * ot_ + tok) * 64 + 8 * kg;     \
        (o_).wr0 = ldfrag(wp_); (o_).wr1 = ldfrag(wp_ + 32); (o_).wi0 = ldfrag(wp_ + 8 * 4096); (o_).wi1 = ldfrag(wp_ + 8 * 4096 + 32); \
        const int ch_ = 64 * g + 16 * ot_ + 4 * kg; \
        (o_).gbr = *(const f32x4*)(gb + (d_ * 2 + 0) * 512 + ch_); (o_).gbi = *(const f32x4*)(gb + (d_ * 2 + 1) * 512 + ch_); (o_).c8 = *(const f32x4*)(c8t + d_ * 512 + ch_); } while (0)
    {
        const float* cw = F.inp(I_LCW) + (size_t)L * 4 * 512 + 64 * g + 8 * kg; const float* cb = F.inp(I_LCB) + (size_t)L * 512 + 64 * g + 8 * kg;
        v4u z[2][4]; f32x4 w0[2][4], w1[2][4], b0[2], b1[2];
#pragma unroll
        for (int ks = 0; ks < 2; ++ks) {
#pragma unroll
            for (int k = 0; k < 4; ++k) { const int Rt = R + k - 2; z[ks][k] = (Rt >= seq_lo && Rt < seq_hi) ? *(const v4u*)(F.Z() + (size_t)Rt * PW + ZC_AX + 64 * g + 32 * ks + 8 * kg) : (v4u){0u, 0u, 0u, 0u};
                w0[ks][k] = *(const f32x4*)(cw + k * 512 + 32 * ks); w1[ks][k] = *(const f32x4*)(cw + k * 512 + 32 * ks + 4); }
            b0[ks] = *(const f32x4*)(cb + 32 * ks); b1[ks] = *(const f32x4*)(cb + 32 * ks + 4);
        }
        LRU_LOAD_OPS(0, ops[0]);
        __builtin_amdgcn_sched_barrier(0);
#pragma unroll
        for (int ks = 0; ks < 2; ++ks) {
            float a[8] = {b0[ks].x, b0[ks].y, b0[ks].z, b0[ks].w, b1[ks].x, b1[ks].y, b1[ks].z, b1[ks].w};
#pragma unroll
            for (int k = 0; k < 4; ++k) { float x[8]; unpack8(z[ks][k], x); const f32x4 u0 = w0[ks][k], u1 = w1[ks][k];
                a[0] += u0.x * x[0]; a[1] += u0.y * x[1]; a[2] += u0.z * x[2]; a[3] += u0.w * x[3]; a[4] += u1.x * x[4]; a[5] += u1.y * x[5]; a[6] += u1.z * x[6]; a[7] += u1.w * x[7]; }
            LAS f32x4* dst = (LAS f32x4*)(xcs + tok * XC_ROW + 32 * ks + 8 * kg);
            dst[0] = (f32x4){a[0], a[1], a[2], a[3]}; dst[1] = (f32x4){a[4], a[5], a[6], a[7]};
        }
    }
    LDS_WAIT(); asm volatile("" ::: "memory");
    bf16x8 xb[2];
    { const LAS float* xr = xcs + tok * XC_ROW;
#pragma unroll
      for (int ks = 0; ks < 2; ++ks) { const f32x4 x0 = *(const LAS f32x4*)(xr + 32 * ks + 8 * kg), x1 = *(const LAS f32x4*)(xr + 32 * ks + 8 * kg + 4);
          v4u pw; pw.x = pk2(x0.x, x0.y); pw.y = pk2(x0.z, x0.w); pw.z = pk2(x1.x, x1.y); pw.w = pk2(x1.z, x1.w); xb[ks] = __builtin_bit_cast(bf16x8, pw); } }
#pragma unroll
    for (int it = 0; it < 8; ++it) {
        if (it + 1 < 8) LRU_LOAD_OPS(it + 1, ops[(it + 1) & 1]);
        __builtin_amdgcn_sched_barrier(0);
        const GateOps& o = ops[it & 1]; const int d = it >> 2, ot = it & 3, ch = 64 * g + 16 * ot + 4 * kg;
        const f32x4 xd = *(const LAS f32x4*)(xcs + tok * XC_ROW + 16 * ot + 4 * kg);
        f32x4 ar = o.gbr, ai = o.gbi;
        ar = mfma16(o.wr0, xb[0], ar); ar = mfma16(o.wr1, xb[1], ar);
        ai = mfma16(o.wi0, xb[0], ai); ai = mfma16(o.wi1, xb[1], ai);
        v4u ov;
#pragma unroll
        for (int e = 0; e < 4; ++e) { const float r = sigm(ar[e]), ig = sigm(ai[e]);
            const float oma = 1.0f - __expf(o.c8[e] * r);
            const float bb = __builtin_amdgcn_sqrtf(oma * (2.0f - oma)) * (ig * xd[e]);
            ov[e] = pk2(oma, bb); }
        *(v4u*)(F.AB2() + (size_t)d * MALL * 512 + (size_t)R * 512 + ch) = ov;
        __builtin_amdgcn_sched_barrier(0);
    }
#undef LRU_LOAD_OPS
    __syncthreads();
    {
        const int cl = F.tid & 127, seg = F.tid >> 7, ch = 128 * q4 + cl;
        const unsigned* p0 = F.AB2() + (size_t)(R0 + 16 * seg) * 512 + ch; const unsigned* p1 = p0 + (size_t)MALL * 512;
        unsigned w0[16], w1[16];
#pragma unroll
        for (int t = 0; t < 16; ++t) { w0[t] = p0[t * 512]; w1[t] = p1[t * 512]; }
        float Af = 1.f, Bf = 0.f, Ab = 1.f, Bb = 0.f;
#pragma unroll
        for (int t = 0; t < 16; ++t) { const float a = 1.0f - bflo(w0[t]), b = bfhi(w0[t]); Bf = a * Bf + b; Af *= a; }
#pragma unroll
        for (int t = 15; t >= 0; --t) { const float a = 1.0f - bflo(w1[t]), b = bfhi(w1[t]); Bb = a * Bb + b; Ab *= a; }
        float* at = F.AGT() + ((size_t)(4 * mc + seg) * 2) * 512 + ch;
        at[0] = Af; at[512] = Bf; at[(size_t)4 * NCHUNK * 1024] = Ab; at[(size_t)4 * NCHUNK * 1024 + 512] = Bb;
        LAS f32x4* ex = (LAS f32x4*)(F.lds + 40960);
        ex[seg * 128 + cl] = (f32x4){Af, Bf, Ab, Bb};
        __syncthreads();
        if (seg == 0) {
            f32x4 e0 = ex[cl], e1 = ex[128 + cl], e2 = ex[256 + cl], e3 = ex[384 + cl];
            float A = e0.x, B = e0.y; B = e1.x * B + e1.y; A *= e1.x; B = e2.x * B + e2.y; A *= e2.x; B = e3.x * B + e3.y; A *= e3.x;
            float C = e3.z, D = e3.w; D = e2.z * D + e2.w; C *= e2.z; D = e1.z * D + e1.w; C *= e1.z; D = e0.z * D + e0.w; C *= e0.z;
            float* ag = F.AGG() + ((size_t)mc * 2) * 512 + ch;
            ag[0] = A; ag[512] = B; ag[(size_t)NCHUNK * 1024] = C; ag[(size_t)NCHUNK * 1024 + 512] = D;
        }
    }
    __syncthreads();
}
__device__ __forceinline__ void lru_d_unit(Frame& F, int u) {
    const int mc = u >> 2, q4 = u & 3;
    const int cl = F.tid & 127, seg = F.tid >> 7, ch = 128 * q4 + cl, R0 = 64 * mc + 16 * seg;
    const unsigned* p0 = F.AB2() + (size_t)R0 * 512 + ch; const unsigned* p1 = p0 + (size_t)MALL * 512;
    const bf16* yp = F.Z() + (size_t)R0 * PW + ZC_AY + ch; bf16* op = F.MIX() + (size_t)R0 * DM + ch;
    unsigned w0[16], w1[16]; bf16 yv[16];
#pragma unroll
    for (int t = 0; t < 16; ++t) { w0[t] = p0[t * 512]; w1[t] = p1[t * 512]; yv[t] = yp[(size_t)t * PW]; }
    float taf[4][2], tab[4][2];
    { const float* atf = F.AGT() + ch; const float* atb = F.AGT() + (size_t)4 * NCHUNK * 1024 + ch;
#pragma unroll
      for (int sgi = 0; sgi < 4; ++sgi) { const float* a = atf + (size_t)(4 * mc + sgi) * 1024; const float* c = atb + (size_t)(4 * mc + sgi) * 1024; taf[sgi][0] = a[0]; taf[sgi][1] = a[512]; tab[sgi][0] = c[0]; tab[sgi][1] = c[512]; } }
    __builtin_amdgcn_sched_barrier(0);
    const float* agf = F.AGG() + ch; const float* agb = F.AGG() + (size_t)NCHUNK * 1024 + ch;
    float hf = 0.f, hb = 0.f;
    const bool lat = mc < 256; const int b = lat ? (mc >> 5) : ((mc - 256) >> 2), lc = lat ? (mc & 31) : ((mc - 256) & 3);
    const int cbase = 256 + 4 * b, lbase = 32 * b;
    const int nfc = lat ? 4 : lc, nfl = lat ? lc : 0, nbc = lat ? 4 : 3 - lc, nbl = lat ? 31 - lc : 0;
#pragma unroll 4
    for (int p = 0; p < 4; ++p) {
        if (p < nfc) { const float* a = agf + (size_t)(cbase + p) * 1024; hf = a[0] * hf + a[512]; }
        if (p < nbc) { const float* a = agb + (size_t)(cbase + 3 - p) * 1024; hb = a[0] * hb + a[512]; }
    }
    { const int nmax = nfl > nbl ? nfl : nbl;
#pragma unroll 8
      for (int p = 0; p < nmax; ++p) {
          const int pf = p < nfl ? p : 0, pb = p < nbl ? p : 0;
          const float* a = agf + (size_t)(lbase + pf) * 1024; const float* c = agb + (size_t)(lbase + 31 - pb) * 1024;
          const float a0 = a[0], a1 = a[512], c0 = c[0], c1 = c[512];
          hf = p < nfl ? a0 * hf + a1 : hf; hb = p < nbl ? c0 * hb + c1 : hb; } }
#pragma unroll
    for (int sgi = 0; sgi < 3; ++sgi) hf = sgi < seg ? taf[sgi][0] * hf + taf[sgi][1] : hf;
#pragma unroll
    for (int sgi = 3; sgi > 0; --sgi) hb = sgi > seg ? tab[sgi][0] * hb + tab[sgi][1] : hb;
    float hfv[16];
#pragma unroll
    for (int t = 0; t < 16; ++t) { hf = (1.0f - bflo(w0[t])) * hf + bfhi(w0[t]); hfv[t] = hf; }
#pragma unroll
    for (int t = 15; t >= 0; --t) { hb = (1.0f - bflo(w1[t])) * hb + bfhi(w1[t]); op[(size_t)t * DM] = (bf16)f2bf((hfv[t] + hb) * gelu_t(bf1(yv[t]))); }
}

constexpr int AT_CTX_OFF = 61440, AT_RPB_OFF = AT_CTX_OFF + 65536;
constexpr int AT_ROPE_OFF = AT_RPB_OFF + 2560;
static_assert(AT_ROPE_OFF % 16 == 0 && AT_ROPE_OFF + 8192 <= PTR_OFF, "attention LDS map");
constexpr int AT_BX_OFF = AT_CTX_OFF + 32768;
struct AtUnit { int bh, r0, c0, qrow0; };
template <bool WIN> __device__ __forceinline__ void at_geom(const AtUnit& u, int& rs0, int& nlr, int& kc0) {
    rs0 = u.r0 - 4 < 0 ? 0 : (u.r0 - 4 > 24 ? 24 : u.r0 - 4); const int rl = u.r0 + 7 - 4 > 24 ? 24 : u.r0 + 7 - 4; nlr = WIN ? rl + 8 - rs0 : 0;
    kc0 = u.c0 - 8 < 0 ? 0 : (u.c0 - 8 > 32 ? 32 : u.c0 - 8);
}
template <bool WIN, int PART = 0  > __device__ __forceinline__ void at_load_k(Frame& F, int tid, const AtUnit& u, v4u (&reg)[12], float& rpbv, int L) {
    int rs0, nlr, kc0; at_geom<WIN>(u, rs0, nlr, kc0);
    if constexpr (WIN && PART != 2) rpbv = F.inp(I_RPB)[((size_t)L * NH + (u.bh & 15)) * 465 + (tid < 465 ? tid : 464)];
    if constexpr (WIN && PART != 2) {
#pragma unroll
        for (int jj = 0; jj < 8; ++jj) { const int n = tid + 512 * jj; const int i = n & 15, c = (n >> 4) & 7, tile = n >> 7, T = tile & 1; int lr = tile >> 1; lr = lr < nlr ? lr : nlr - 1;
            reg[jj] = *(const v4u*)(F.KR() + ((size_t)u.bh * SEQ + (rs0 + lr) * 64 + kc0 + 8 * (i >> 2) + 4 * T + (i & 3)) * 64 + 8 * c); }
    }
    if constexpr (PART != 1)
#pragma unroll
    for (int jj = 0; jj < 4; ++jj) { const int n = tid + 512 * jj, i = n & 15, c = (n >> 4) & 7, tile = n >> 7;
        reg[8 + jj] = *(const v4u*)(F.KC() + ((size_t)u.bh * CTXL + 32 * (tile >> 1) + 8 * (i >> 2) + 4 * (tile & 1) + (i & 3)) * 64 + 8 * c); }
}
template <bool WIN> __device__ __forceinline__ void at_load_v(Frame& F, int tid, const AtUnit& u, v4u (&reg)[12]) {
    int rs0, nlr, kc0; at_geom<WIN>(u, rs0, nlr, kc0);
    const int h = u.bh & 15, b = u.bh >> 4, c = tid & 7, col = (tid >> 3) & 31, lr0 = tid >> 8;
    if constexpr (WIN) {
        const bf16* base = F.VT() + ((size_t)u.bh * SEQ + rs0 * 64 + kc0) * 64;
        const unsigned lane_off = (unsigned)(col * 64 + 8 * c);
#pragma unroll
        for (int jj = 0; jj < 8; ++jj) { int lr = lr0 + 2 * jj; lr = lr < nlr ? lr : nlr - 1;
            reg[jj] = *(const v4u*)(base + (lane_off + (unsigned)lr * 4096u)); }
    }
    { const bf16* base = F.Z() + ((size_t)MLAT + b * CTXL) * PW + ZC_V + 64 * h;
#pragma unroll
      for (int jj = 0; jj < 4; ++jj) reg[8 + jj] = *(const v4u*)(base + ((unsigned)((tid >> 3) + 64 * jj) * (unsigned)PW + 8 * c)); }
}
__device__ __forceinline__ int at_vswz(int tid) { const int r = (tid >> 3) & 31; return (((r >> 1) & 1) | (((r >> 3) & 1) << 1)) << 5; }
template <bool WIN, bool VIMG = false> __device__ __forceinline__ void at_store(Frame& F, int tid, const AtUnit& u, const v4u (&reg)[12]) {
    int rs0, nlr, kc0; at_geom<WIN>(u, rs0, nlr, kc0);
    const int x = VIMG ? at_vswz(tid) : 0;
    if constexpr (WIN) {
#pragma unroll
        for (int jj = 0; jj < 8; ++jj) { const int n = tid + 512 * jj; if (n < nlr * 256) *(LAS v4u*)(F.lds + ((n * 16) ^ x)) = reg[jj]; }
    }
#pragma unroll
    for (int jj = 0; jj < 4; ++jj) { const int n = tid + 512 * jj; *(LAS v4u*)(F.lds + AT_CTX_OFF + ((n * 16) ^ x)) = reg[8 + jj]; }
}
#define AT_LDS_FRAG(off) (*(const LAS bf16x8*)(F.lds + (off)))
struct AtStat { float m1, l1, m2, l2; };
__device__ __forceinline__ float vmax3(float a, float b, float c) { float r; asm("v_max3_f32 %0, %1, %2, %3" : "=v"(r) : "v"(a), "v"(b), "v"(c)); return r; }
template <int NTILE> __device__ __forceinline__ void at_softmax_part(const f32x4 (&S)[NTILE], v4u* pw, float& m_out, float& l_out, int lane) {
    float ma = vmax3(S[0][0], S[0][1], S[0][2]), mb = vmax3(S[1][0], S[1][1], S[1][2]);
    ma = vmax3(ma, S[0][3], S[1][3]);
#pragma unroll
    for (int t = 2; t < NTILE; t += 2) { ma = vmax3(ma, S[t][0], S[t][1]); mb = vmax3(mb, S[t][2], S[t][3]); ma = vmax3(ma, S[t + 1][0], S[t + 1][1]); mb = vmax3(mb, S[t + 1][2], S[t + 1][3]); }
    float m = fmaxf(ma, mb);
    m = fmaxf(m, shx(m, 16, lane)); m = fmaxf(m, shx(m, 32, lane));
    const f32x2_t m2 = {m, m}; f32x2_t sum2 = {0.f, 0.f};
#pragma unroll
    for (int ks = 0; ks < NTILE / 2; ++ks) {
        unsigned w[4];
#pragma unroll
        for (int hh = 0; hh < 4; ++hh) {
            const f32x4 s4 = S[2 * ks + (hh >> 1)];
            const f32x2_t d = (f32x2_t){s4[2 * (hh & 1)], s4[2 * (hh & 1) + 1]} - m2;
            const f32x2_t pr = {__builtin_amdgcn_exp2f(d.x), __builtin_amdgcn_exp2f(d.y)};
            sum2 += pr; w[hh] = pk2(pr.x, pr.y);
        }
        pw[ks] = (v4u){w[0], w[1], w[2], w[3]};
    }
    float sum = sum2.x + sum2.y;
    sum += shx(sum, 16, lane); sum += shx(sum, 32, lane);
    m_out = m; l_out = sum;
}
__device__ __forceinline__ void at_build_bias(Frame& F, int tid, int c0, int kc0) {
    const LAS float* rpb = (const LAS float*)(F.lds + AT_RPB_OFF);
#pragma unroll
    for (int jj = 0; jj < 4; ++jj) { const int n = tid + 512 * jj;
        if (n < 15 * 128) { const int row = n >> 7, T = (n >> 6) & 1, kg = (n >> 4) & 3, q = n & 15;
            const int qcol = c0 + q, cs = qcol - 8 < 0 ? 0 : (qcol - 8 > 48 ? 48 : qcol - 8), kcol0 = kc0 + 8 * kg + 4 * T;
            f32x4 v;
#pragma unroll
            for (int e = 0; e < 4; ++e) { const int kcol = kcol0 + e; int rc = kcol - qcol + 15; rc = rc < 0 ? 0 : (rc > 30 ? 30 : rc);
                float bv = rpb[row * 31 + rc]; asm volatile("" : "+v"(bv));
                v[e] = (kcol >= cs && kcol < cs + 16) ? bv : -1e30f; }
            *(LAS f32x4*)(F.lds + AT_BX_OFF + n * 16) = v; } }
}
struct AtQ { bf16x8 w0, w1; };
template <bool WIN> __device__ __forceinline__ void at_load_q(Frame& F, int tid, const AtUnit& u, AtQ& Q) {
    const int lane = tid & 63, q = lane & 15, kg = lane >> 4;
    const int r = u.r0 + F.wave, h = u.bh & 15, b = u.bh >> 4;
    const size_t qrow = WIN ? (size_t)(b * SEQ + r * 64 + u.c0 + q) : (size_t)(u.qrow0 + 16 * F.wave + q);
    const bf16* qraw = WIN ? F.QR() + ((size_t)u.bh * SEQ + r * 64 + u.c0 + q) * 64 + 8 * kg : F.Z() + qrow * PW + ZC_Q + 64 * h + 8 * kg;
    Q.w0 = ldfrag(qraw); Q.w1 = ldfrag(qraw + 32);
}
template <bool WIN> __device__ __forceinline__ void at_scores(Frame& F, int tid, const AtUnit& u, int L, const AtQ& Q, v4u* pw, AtStat& st, v4u (&rv)[12]) {
    const int lane = tid & 63, q = lane & 15, kg = lane >> 4;
    const f32x4 z4 = (f32x4){0.f, 0.f, 0.f, 0.f};
    int rs0, nlr, kc0; at_geom<WIN>(u, rs0, nlr, kc0);
    const int r = u.r0 + F.wave, rs = r - 4 < 0 ? 0 : (r - 4 > 24 ? 24 : r - 4), lr0 = rs - rs0;
    const int foff = (kg * 16 + q) * 16;
    st.m1 = -3e38f; st.l1 = 0.f;
    if constexpr (WIN) {
        const int boff = AT_BX_OFF + (rs - r + 7) * 2048 + foff;
        bf16x8 qr0, qr1;
        { const bool is_x2 = (kg >> 1) & 1; const int f0 = 8 * (kg & 1), qcol = u.c0 + q;
          const LAS f32x4* tr = (const LAS f32x4*)(F.lds + AT_ROPE_OFF + (r * 32 + 2 * f0) * 4); const LAS f32x4* tc = (const LAS f32x4*)(F.lds + AT_ROPE_OFF + (qcol * 32 + 2 * f0) * 4);
          f32x4 cr[4], cc[4];
#pragma unroll
          for (int e = 0; e < 4; ++e) { cr[e] = tr[e]; cc[e] = tc[e]; }
          const v4u a0 = __builtin_bit_cast(v4u, Q.w0), a1 = __builtin_bit_cast(v4u, Q.w1);
          v4u p0, p1; p0.x = shxu(a0.x, 32, lane); p0.y = shxu(a0.y, 32, lane); p0.z = shxu(a0.z, 32, lane); p0.w = shxu(a0.w, 32, lane);
          p1.x = shxu(a1.x, 32, lane); p1.y = shxu(a1.y, 32, lane); p1.z = shxu(a1.z, 32, lane); p1.w = shxu(a1.w, 32, lane);
          float x[8], pp[8], o[8];
          unpack8(a0, x); unpack8(p0, pp);
#pragma unroll
          for (int e = 0; e < 8; ++e) { const float c = cr[e >> 1][2 * (e & 1)], s = cr[e >> 1][2 * (e & 1) + 1]; o[e] = is_x2 ? (x[e] * c + pp[e] * s) : (x[e] * c - pp[e] * s); }
          qr0 = __builtin_bit_cast(bf16x8, pack8(o));
          unpack8(a1, x); unpack8(p1, pp);
#pragma unroll
          for (int e = 0; e < 8; ++e) { const float c = cc[e >> 1][2 * (e & 1)], s = cc[e >> 1][2 * (e & 1) + 1]; o[e] = is_x2 ? (x[e] * c + pp[e] * s) : (x[e] * c - pp[e] * s); }
          qr1 = __builtin_bit_cast(bf16x8, pack8(o)); }
        const int koff = lr0 * 4096 + foff;
        struct WT { bf16x8 k0, k1; f32x4 c; };
        WT wb[2][2];
#define AT_WLOAD(ir_, b_) do { _Pragma("unroll") for (int T = 0; T < 2; ++T) { const int to_ = koff + (ir_) * 4096 + T * 2048; (b_)[T].k0 = AT_LDS_FRAG(to_); (b_)[T].k1 = AT_LDS_FRAG(to_ + 1024); \
            (b_)[T].c = *(const LAS f32x4*)(F.lds + boff + (ir_) * 2048 + T * 1024); } } while (0)
        f32x4 S[16];
        AT_WLOAD(0, wb[0]);
#pragma unroll
        for (int ir = 0; ir < 8; ++ir) {
            if (ir + 1 < 8) AT_WLOAD(ir + 1, wb[(ir + 1) & 1]);
            __builtin_amdgcn_sched_barrier(0);
            const WT (&w)[2] = wb[ir & 1];
            const f32x4 a0 = mfma16(w[0].k0, qr0, w[0].c), a1 = mfma16(w[1].k0, qr0, w[1].c);
            S[2 * ir] = mfma16(w[0].k1, qr1, a0); S[2 * ir + 1] = mfma16(w[1].k1, qr1, a1);
            __builtin_amdgcn_sched_barrier(0);
        }
#undef AT_WLOAD
        at_softmax_part<16>(S, pw, st.m1, st.l1, lane);
    }
    {
        struct CT { bf16x8 k0, k1; };
        CT cb[2][2];
#define AT_CLOAD(s_, b_) do { _Pragma("unroll") for (int T = 0; T < 2; ++T) { const int to_ = AT_CTX_OFF + (2 * (s_) + T) * 2048 + foff; (b_)[T].k0 = AT_LDS_FRAG(to_); (b_)[T].k1 = AT_LDS_FRAG(to_ + 1024); } } while (0)
        f32x4 S[16];
        AT_CLOAD(0, cb[0]);
#pragma unroll
        for (int s = 0; s < 8; ++s) {
            if (s + 1 < 8) AT_CLOAD(s + 1, cb[(s + 1) & 1]);
            __builtin_amdgcn_sched_barrier(0);
            const CT (&w)[2] = cb[s & 1];
            const f32x4 a0 = mfma16(w[0].k0, Q.w0, z4), a1 = mfma16(w[1].k0, Q.w0, z4);
            S[2 * s] = mfma16(w[0].k1, Q.w1, a0); S[2 * s + 1] = mfma16(w[1].k1, Q.w1, a1);
            __builtin_amdgcn_sched_barrier(0);
        }
#undef AT_CLOAD
        at_softmax_part<16>(S, pw + (WIN ? 8 : 0), st.m2, st.l2, lane);
    }
}
template <bool WIN> __device__ __forceinline__ void at_pv(Frame& F, int tid, const AtUnit& u, const v4u* pw, const AtStat& st) {
    const int lane = tid & 63, q = lane & 15, kg = lane >> 4;
    const f32x4 z4 = (f32x4){0.f, 0.f, 0.f, 0.f};
    int rs0, nlr, kc0; at_geom<WIN>(u, rs0, nlr, kc0);
    const int r = u.r0 + F.wave, rs = r - 4 < 0 ? 0 : (r - 4 > 24 ? 24 : r - 4), lr0 = rs - rs0;
    const int h = u.bh & 15, b = u.bh >> 4;
    typedef short s4v __attribute__((ext_vector_type(4)));
    const int qq = (lane >> 2) & 3, pp = lane & 3, sgm = ((qq >> 1) & 1) | ((kg & 1) << 1);
    const int rowoff = (8 * kg + qq) * 128 + 8 * pp;
    constexpr int NKS = WIN ? 16 : 8;
    const int wbase = lr0 * 4096 + rowoff, cbase = AT_CTX_OFF + rowoff;
    f32x4 O[4] = {z4, z4, z4, z4}, Ow[4] = {z4, z4, z4, z4};
    bf16x8 vf[3][4];
#define AT_VLOAD(ks_, b_) do { const int vo_ = (WIN && (ks_) < 8) ? wbase + (ks_) * 4096 : cbase + ((ks_) - (WIN ? 8 : 0)) * 4096; \
        _Pragma("unroll") for (int dt = 0; dt < 4; ++dt) { const int a_ = vo_ + ((dt ^ sgm) << 5); \
            const s4v lo_ = __builtin_amdgcn_ds_read_tr16_b64_v4i16((LAS s4v*)(F.lds + a_)), hi_ = __builtin_amdgcn_ds_read_tr16_b64_v4i16((LAS s4v*)(F.lds + a_ + 512)); \
            (b_)[dt] = __builtin_shufflevector(lo_, hi_, 0, 1, 2, 3, 4, 5, 6, 7); } } while (0)
    AT_VLOAD(0, vf[0]); AT_VLOAD(1, vf[1]);
#pragma unroll
    for (int ks = 0; ks < NKS; ++ks) {
        if (ks + 2 < NKS) AT_VLOAD(ks + 2, vf[(ks + 2) % 3]);
        __builtin_amdgcn_sched_barrier(0);
        const bf16x8 pf = __builtin_bit_cast(bf16x8, pw[ks]);
        if (WIN && ks < 8) {
#pragma unroll
            for (int dt = 0; dt < 4; ++dt) Ow[dt] = mfma16(vf[ks % 3][dt], pf, Ow[dt]);
        } else {
#pragma unroll
            for (int dt = 0; dt < 4; ++dt) O[dt] = mfma16(vf[ks % 3][dt], pf, O[dt]);
        }
        __builtin_amdgcn_sched_barrier(0);
    }
#undef AT_VLOAD
    float lsum = st.l2;
    if constexpr (WIN) {
        const float m = fmaxf(st.m1, st.m2), f1 = __builtin_amdgcn_exp2f(st.m1 - m), f2 = __builtin_amdgcn_exp2f(st.m2 - m);
#pragma unroll
        for (int dt = 0; dt < 4; ++dt) O[dt] = O[dt] * f2 + Ow[dt] * f1;
        lsum = st.l2 * f2 + st.l1 * f1;
    }
    const float inv = __builtin_amdgcn_rcpf(lsum);
    const size_t orow = WIN ? (size_t)(b * SEQ + r * 64 + u.c0 + q) : (size_t)(u.qrow0 + 16 * F.wave + q);
    bf16* out = F.MIX() + orow * DM + 512 + 64 * h + 4 * kg;
#pragma unroll
    for (int dt = 0; dt < 4; ++dt) { v2u w; w.x = pk2(O[dt][0] * inv, O[dt][1] * inv); w.y = pk2(O[dt][2] * inv, O[dt][3] * inv); *(v2u*)(out + 16 * dt) = w; }
}
#undef AT_LDS_FRAG
#define AT_BAR() asm volatile("s_waitcnt lgkmcnt(0)\n\ts_barrier" ::: "memory")
template <bool WIN, bool QUEUE, class UnitFn> __device__ __forceinline__ void attn_units(Frame& F, int L, int nunits, UnitFn unit_of, unsigned* qctr) {
    if (nunits <= 0) return;
    v4u rk[12], rv[12]; float rpbv = 0.f;
    volatile LAS int* qslot = (volatile LAS int*)(F.lds + AT_RPB_OFF + 2048);
    int cur = 0, nxt = 1;
    if constexpr (QUEUE) {
        if (F.tid == 0) { qslot[0] = (int)__hip_atomic_fetch_add(qctr, 1u, __ATOMIC_RELAXED, __HIP_MEMORY_SCOPE_AGENT); qslot[1] = (int)__hip_atomic_fetch_add(qctr, 1u, __ATOMIC_RELAXED, __HIP_MEMORY_SCOPE_AGENT); }
        __syncthreads();
        cur = __builtin_amdgcn_readfirstlane(qslot[0]); nxt = __builtin_amdgcn_readfirstlane(qslot[1]);
        __syncthreads();
        if (cur >= nunits) return;
    }
    if constexpr (WIN) *(LAS f32x4*)(F.lds + AT_ROPE_OFF + F.tid * 16) = *(const f32x4*)(F.ROPE() + F.tid * 4);
    AtUnit u = unit_of(cur);
#define AT_OPQ(x) ({ int o_ = (x); asm volatile("" : "+v"(o_)); o_; })
    at_load_k<WIN>(F, AT_OPQ(F.tid), u, rk, rpbv, L);
    AtQ Q; at_load_q<WIN>(F, AT_OPQ(F.tid), u, Q);
#pragma unroll 1
    for (;;) {
        const int tid = AT_OPQ(F.tid);
        int nn = nxt + 1;
        int fetched = 0;
        if constexpr (QUEUE) { if (tid == 0) { int zo_ = 0; asm volatile("" : "+v"(zo_));
                fetched = (int)__hip_atomic_fetch_add(qctr + zo_, 1u, __ATOMIC_RELAXED, __HIP_MEMORY_SCOPE_AGENT); } }
        AT_BAR();
        at_store<WIN>(F, AT_OPQ(tid), u, rk);
        if (WIN && tid < 465) *(LAS float*)(F.lds + AT_RPB_OFF + 4 * tid) = rpbv * 1.4426950408889634f;
        at_load_v<WIN>(F, AT_OPQ(tid), u, rv);
        if constexpr (WIN) { const AtUnit un0 = unit_of(nxt < nunits ? nxt : cur); at_load_k<WIN, 2>(F, AT_OPQ(tid), un0, rk, rpbv, L); }
        __builtin_amdgcn_sched_barrier(0);
        AT_BAR();
        if constexpr (WIN) { int rs0_, nlr_, kc0_; at_geom<WIN>(u, rs0_, nlr_, kc0_); at_build_bias(F, AT_OPQ(tid), u.c0, kc0_); AT_BAR(); }
        v4u pw[WIN ? 16 : 8]; AtStat st;
        at_scores<WIN>(F, AT_OPQ(tid), u, L, Q, pw, st, rv);
        if constexpr (QUEUE) { if (tid == 0) qslot[0] = fetched; }
        AT_BAR();
        if constexpr (QUEUE) nn = __builtin_amdgcn_readfirstlane(qslot[0]);
        const bool more = nxt < nunits;
        const AtUnit un = unit_of(more ? nxt : cur);
        at_store<WIN, true>(F, AT_OPQ(tid), u, rv);
        if constexpr (WIN) at_load_k<WIN, 1>(F, AT_OPQ(tid), un, rk, rpbv, L); else at_load_k<WIN>(F, AT_OPQ(tid), un, rk, rpbv, L);
        at_load_q<WIN>(F, AT_OPQ(tid), un, Q);
        AT_BAR();
        at_pv<WIN>(F, AT_OPQ(tid), u, pw, st);
        if (!more) break;
        u = un; cur = nxt; nxt = nn;
    }
    __syncthreads();
}
#undef AT_OPQ
#undef AT_BAR

constexpr int SG_ROW = 132;
__device__ __forceinline__ void sgu_unit(Frame& F, int L, int ck) {
    const int lane = F.lane, w = F.wave; const size_t row0 = (size_t)128 * ck;
    LAS bf16* vnT = (LAS bf16*)F.lds;
    const float* lg = F.inp(I_SLG) + (size_t)L * 512 + 8 * lane; const float* lb = F.inp(I_SLB) + (size_t)L * 512 + 8 * lane;
    float g8[8], b8[8];
#pragma unroll
    for (int e = 0; e < 8; ++e) { g8[e] = lg[e]; b8[e] = lb[e]; }
    for (int t4 = 0; t4 < 4; ++t4) {
        float x[4][8], s[4], q[4];
#pragma unroll
        for (int i = 0; i < 4; ++i) unpack8(*(const v4u*)(F.Z() + (row0 + 16 * w + 4 * t4 + i) * PW + ZC_SV + 8 * lane), x[i]);
#pragma unroll
        for (int i = 0; i < 4; ++i) { s[i] = 0.f;
#pragma unroll
            for (int e = 0; e < 8; ++e) { x[i][e] = gelu_t(x[i][e]); s[i] += x[i][e]; } }
#pragma unroll
        for (int o = 1; o < 64; o <<= 1)
#pragma unroll
            for (int i = 0; i < 4; ++i) s[i] += shx(s[i], o, lane);
#pragma unroll
        for (int i = 0; i < 4; ++i) { const float mean = s[i] * (1.0f / 512.0f); q[i] = 0.f;
#pragma unroll
            for (int e = 0; e < 8; ++e) { x[i][e] -= mean; q[i] += x[i][e] * x[i][e]; } }
#pragma unroll
        for (int o = 1; o < 64; o <<= 1)
#pragma unroll
            for (int i = 0; i < 4; ++i) q[i] += shx(q[i], o, lane);
#pragma unroll
        for (int i = 0; i < 4; ++i) { const int tok = 16 * w + 4 * t4 + i; const float rstd = __builtin_amdgcn_rsqf(q[i] * (1.0f / 512.0f) + NORM_EPS);
#pragma unroll
            for (int e = 0; e < 8; ++e) { const int e2 = (e + lane) & 7;
                float val = 0.f;
#pragma unroll
                for (int k = 0; k < 8; ++k) if (k == e2) val = x[i][k] * rstd * g8[k] + b8[k];
                vnT[(8 * lane + e2) * SG_ROW + tok] = (bf16)f2bf(val); } }
    }
    __syncthreads();
    {
        const int g = w, dl = lane & 15, kg = lane >> 4;
        typedef unsigned long long u64;
        bf16x8 A[4][4];
#pragma unroll
        for (int dt = 0; dt < 4; ++dt)
#pragma unroll
            for (int ks = 0; ks < 4; ++ks) { const LAS u64* p = (const LAS u64*)(vnT + (64 * g + 16 * dt + dl) * SG_ROW + 32 * ks + 8 * kg);
                const u64 lo = p[0], hi = p[1]; v4u wv; wv.x = (unsigned)lo; wv.y = (unsigned)(lo >> 32); wv.z = (unsigned)hi; wv.w = (unsigned)(hi >> 32); A[dt][ks] = __builtin_bit_cast(bf16x8, wv); }
        const bf16* Wg = F.SWB() + ((size_t)L * 8 + g) * 16384; const float* sb = F.inp(I_SB) + ((size_t)L * 8 + g) * 128;
        struct SgOps { bf16x8 Bf[4]; float bias; v2u uw[4]; };
        SgOps so[2];
#define SG_LOAD(pt_, o_) do { const int p_ = 16 * (pt_) + dl; \
            _Pragma("unroll") for (int ks = 0; ks < 4; ++ks) (o_).Bf[ks] = ldfrag(Wg + p_ * 128 + 32 * ks + 8 * kg); \
            (o_).bias = sb[p_]; \
            _Pragma("unroll") for (int dt = 0; dt < 4; ++dt) (o_).uw[dt] = *(const v2u*)(F.Z() + (row0 + p_) * PW + ZC_SU + 64 * g + 16 * dt + 4 * kg); } while (0)
        SG_LOAD(0, so[0]);
#pragma unroll
        for (int pt = 0; pt < 8; ++pt) {
            if (pt + 1 < 8) SG_LOAD(pt + 1, so[(pt + 1) & 1]);
            __builtin_amdgcn_sched_barrier(0);
            const SgOps& o = so[pt & 1]; const int p = 16 * pt + dl;
#pragma unroll
            for (int dt = 0; dt < 4; ++dt) {
                f32x4 acc = (f32x4){0.f, 0.f, 0.f, 0.f};
#pragma unroll
                for (int ks = 0; ks < 4; ++ks) acc = mfma16(A[dt][ks], o.Bf[ks], acc);
                const int d = 64 * g + 16 * dt + 4 * kg; const v2u uw = o.uw[dt];
                const float o0 = gelu_t(bflo(uw.x)) * (acc[0] + o.bias), o1 = gelu_t(bfhi(uw.x)) * (acc[1] + o.bias), o2 = gelu_t(bflo(uw.y)) * (acc[2] + o.bias), o3 = gelu_t(bfhi(uw.y)) * (acc[3] + o.bias);
                v2u ow; ow.x = pk2(o0, o1); ow.y = pk2(o2, o3);
                *(v2u*)(F.MIX() + (row0 + p) * DM + 1536 + d) = ow;
            }
            __builtin_amdgcn_sched_barrier(0);
        }
#undef SG_LOAD
    }
    __syncthreads();
}

#ifndef MK_PER_PHASE
#define MK_PER_PHASE 0
#endif
constexpr int PH_PER_LAYER = 9, NPH = 2 + DEPTH * PH_PER_LAYER + 1;

struct OffOrder : pg8::StaticOrder { int pm0;
    __device__ __forceinline__ bool next(int i, pg8::Unit& u) const { const bool ok = pg8::StaticOrder::next(i, u); u.pm += pm0; return ok; } };

__global__ void __launch_bounds__(NTHREADS, 2) fwd_kernel(Args args) {
    extern __shared__ __attribute__((aligned(16))) unsigned char lds_raw[];
    Frame F;
    F.lds = (LAS unsigned char*)lds_raw;
    F.tid = threadIdx.x; F.lane = F.tid & 63; F.wave = __builtin_amdgcn_readfirstlane(F.tid >> 6); F.G = gridDim.x; F.bid = blockIdx.x;
    F.ws = args.ws; F.out = args.out;
    unsigned char* ws = args.ws;
    if (F.tid == 0) {
#pragma unroll
        for (int i = 0; i < 25; ++i) *(LAS unsigned long long*)(F.lds + PTR_OFF + 8 * i) = (unsigned long long)args.in[i];
    }
    volatile LAS unsigned* MISC = (volatile LAS unsigned*)(F.lds + MISC_OFF);
    if (F.tid < 32) MISC[F.tid] = 0u;
    __syncthreads();
    XcdBarrier bar; bar.bar = (unsigned*)(ws + WS_CTL) + CW_BAR; bar.x = 0; bar.st = nullptr;
    if (!MK_PER_PHASE) bar = xcd_barrier_post((unsigned*)(ws + WS_CTL) + CW_BAR, MISC + 8);
    const int lo = args.ph_lo, hi = args.ph_hi;
    const int wave_s = __builtin_amdgcn_readfirstlane(threadIdx.x >> 6);
#ifndef PH_MASK
#define PH_MASK 0x7ff
#endif
#define KIND(k) ((k) == 0 ? 0 : ((k) == NPH - 1 ? 10 : 1 + ((k) - 1) % PH_PER_LAYER))
#define IN(k) (lo <= (k) && (k) < hi)
#ifndef SUB_TWICE
#define SUB_TWICE 0
#endif
#define SUBREPS(bit) for (int srep_ = 0; srep_ < 1 + ((SUB_TWICE >> (bit)) & 1); ++srep_)
#ifndef PH_TWICE
#define PH_TWICE 0
#endif
#define REPS(kind) for (int rep_ = 0, nrep_ = 1 + ((PH_TWICE >> (kind)) & 1); rep_ < nrep_; ++rep_)
#define GATE(p) ((PH_TWICE && rep_) ? (const float*)(ws + WS_CTL + 262144) : (p))
#define REP_SYNC() do { if (PH_TWICE && rep_ + 1 < nrep_ && !MK_PER_PHASE) xcd_barrier(bar, F.tid); } while (0)
#define PHASE_BEGIN() do { int l_; asm volatile("v_mbcnt_lo_u32_b32 %0, -1, 0\n\tv_mbcnt_hi_u32_b32 %0, -1, %0" : "=v"(l_)); F.lane = l_; F.wave = wave_s; F.tid = wave_s * 64 + l_; size_t z_ = 0; asm volatile("" : "+s"(z_)); unsigned char* w_ = args.ws + z_; F.ws = w_; ws = w_;     int g_ = gridDim.x, b_ = blockIdx.x; asm volatile("" : "+s"(g_), "+s"(b_)); F.G = g_; F.bid = b_; } while (0)
#define LANE_REFRESH() do { int l_; asm volatile("v_mbcnt_lo_u32_b32 %0, -1, 0\n\tv_mbcnt_hi_u32_b32 %0, -1, %0" : "=v"(l_)); F.lane = l_; F.tid = wave_s * 64 + l_; } while (0)
#define SEAM(k) do { if (!MK_PER_PHASE && IN(k) && IN((k) + 1)) xcd_barrier(bar, F.tid); } while (0)

    const bool G256 = (F.G == 256);
    if (((PH_MASK >> 0) & 1) && IN(0)) { REPS(0) { PHASE_BEGIN(); p0_prologue(F); REP_SYNC(); } SEAM(0); }
    if (IN(1)) { PHASE_BEGIN(); int r0, r1; share(MLAT, MALL, F.bid, F.G, r0, r1); norm_range(F, 0, 0, r0, r1); SEAM(1); }

    for (int L = 0; L < DEPTH; ++L) {
        const int pb = 2 + PH_PER_LAYER * L;
        const bool lastL = (L == DEPTH - 1);
        const bf16* wt = (const bf16*)(ws + WS_WT + (size_t)L * WT_LAYER);
        const float* modL = F.MOD() + (size_t)L * 9 * MODW;

        if (((PH_MASK >> 1) & 1) && IN(pb + 0)) { REPS(1) { PHASE_BEGIN();
            { pg8::Gemm g{F.HX(), (const bf16*)((const char*)wt + WT_IN), MCTX, PW, DM}; OffOrder S; S.init(MCTX, PW, F.G, F.bid); S.pm0 = 64;
              pg8::EpiBf16<0> E{F.Z(), PW, nullptr, 0, 0, 1.f};
              pg8::gemm_phase<pg8::EpiBf16<0>, OffOrder, true, true>(F.lds, g, S, E, F.tid); }
            int r0, r1;
            if (G256) { if (F.bid < 160) { r0 = 16 * F.bid; r1 = r0 + 16; } else { r0 = 2560 + 144 * (F.bid - 160); r1 = r0 + 144; if (r0 > MLAT) r0 = MLAT; if (r1 > MLAT) r1 = MLAT; } }
            else share(0, MLAT, F.bid, F.G, r0, r1);
            norm_range(F, L, 0, r0, r1);
            REP_SYNC(); }
            SEAM(pb + 0);
        }

        if (((PH_MASK >> 2) & 1) && IN(pb + 1)) { REPS(2) { PHASE_BEGIN();
            { pg8::Gemm g{F.HX(), (const bf16*)((const char*)wt + WT_IN), MLAT, PW, DM}; pg8::StaticOrder S; S.init(MLAT, PW, F.G, F.bid);
              pg8::EpiInSplit E{F.Z(), PW, F.QR(), F.KR(), F.VT()};
              pg8::gemm_phase<pg8::EpiInSplit, pg8::StaticOrder, true, true>(F.lds, g, S, E, F.tid); }
            __syncthreads();
            for (int u = 1024 + F.bid; u < 1152; u += F.G) lru_ab_unit(F, L, u);
            if (!G256 || F.bid >= 128) for (int wu = (G256 ? F.bid - 128 : F.bid) * NWAVES + F.wave; wu < 512; wu += (G256 ? F.G - 128 : F.G) * NWAVES) prep_unit(F, true, wu >> 6, (wu >> 2) & 15, wu & 3);
            REP_SYNC(); }
            SEAM(pb + 1);
        }

        if (((PH_MASK >> 3) & 1) && IN(pb + 2)) { REPS(3) { PHASE_BEGIN();
            if (G256 && !lastL) { const int nmine = F.bid >= 240 ? 2 : 4;
                for (int k = 0; k < nmine; ++k) lru_ab_unit(F, L, F.bid + 256 * k);
                if (F.bid >= 128 && F.bid < 144) lru_ab_unit(F, L, 240 + (F.bid - 128) + 256 * 3);
                if (F.bid >= 144 && F.bid < 160) lru_ab_unit(F, L, 240 + (F.bid - 144) + 256 * 2); }
            else for (int u = F.bid; u < 1024; u += F.G) lru_ab_unit(F, L, u);
            for (int wu = F.bid * NWAVES + F.wave; wu < 4096; wu += F.G * NWAVES) prep_unit(F, false, wu >> 9, (wu >> 5) & 15, wu & 31);
            if (!lastL) {
                for (int u = 1024 + F.bid; u < 1152; u += F.G) lru_d_unit(F, u);
                __syncthreads();
                LANE_REFRESH();
                const int xcd = F.bid & 7, slot = F.bid >> 3;
                attn_units<false, false>(F, L, G256 ? 1 : (256 - F.bid + F.G - 1) / F.G, [&](int i) { const int uu = G256 ? (xcd * 16 + (slot >> 1)) * 2 + (slot & 1) : F.bid + i * F.G; const int bh = uu >> 1;
                    return AtUnit{bh, 0, 0, MLAT + (bh >> 4) * CTXL + 128 * (uu & 1)}; }, nullptr);
                __syncthreads();
                LANE_REFRESH();
                if (F.G >= 16) { if (F.bid >= F.G - 16) sgu_unit(F, L, 128 + F.bid - (F.G - 16)); } else for (int uu = 128 + F.bid; uu < 144; uu += F.G) sgu_unit(F, L, uu);
            }
            REP_SYNC(); }
            SEAM(pb + 2);
        }

        if (((PH_MASK >> 4) & 1) && IN(pb + 3)) { REPS(4) { PHASE_BEGIN();
            if (!lastL) { pg8::Gemm g{F.MIX(), (const bf16*)((const char*)wt + WT_OUT), MCTX, DM, DM}; OffOrder S; S.init(MCTX, DM, F.G, F.bid); S.pm0 = 64;
              const bool in32 = (L == 0 && !(PH_TWICE && rep_)); pg8::EpiResGateB16 E{in32 ? F.inp(I_X) : nullptr, in32 ? F.inp(I_CTX) - (size_t)MLAT * DM : nullptr, F.X(), F.X(), GATE(modL + 2 * DM)};
              pg8::gemm_phase<pg8::EpiResGateB16, OffOrder, true, true>(F.lds, g, S, E, F.tid);
              __syncthreads(); }
            {
            SUBREPS(4) for (int u = F.bid; u < 1024; u += F.G) lru_d_unit(F, u);
            __syncthreads();
            LANE_REFRESH();
            SUBREPS(5) { if (F.G >= 128) { if (F.bid >= F.G - 128) sgu_unit(F, L, F.bid - (F.G - 128)); } else for (int uu = F.bid; uu < 128; uu += F.G) sgu_unit(F, L, uu); }
            __syncthreads();
            LANE_REFRESH();
            SUBREPS(2) { const bool grp = (F.G % 8 == 0); const int xg = grp ? (F.bid & 7) : 0; unsigned* qc = (unsigned*)(ws + WS_CTL) + CW_Q + (L * 8 + xg) * 64 + 2048 * (srep_ + rep_);
              attn_units<true, true>(F, L, grp ? 256 : 2048, [&](int n) {
                const int bl = n >> 4, bh = grp ? ((bl >> 1) * 16 + 2 * xg + (bl & 1)) : bl, sub = n & 15;
                return AtUnit{bh, 8 * (sub >> 2), 16 * (sub & 3), 0}; }, qc); }
            }
            REP_SYNC(); }
            SEAM(pb + 3);
        }

        if (((PH_MASK >> 5) & 1) && IN(pb + 4)) { REPS(5) { PHASE_BEGIN();
            { pg8::Gemm g{F.MIX(), (const bf16*)((const char*)wt + WT_OUT), MLAT, DM, DM}; pg8::StaticOrder S; S.init(MLAT, DM, F.G, F.bid);
              const bool in32 = (L == 0 && !(PH_TWICE && rep_)); pg8::EpiResGateB16 E{in32 ? F.inp(I_X) : nullptr, in32 ? F.inp(I_CTX) - (size_t)MLAT * DM : nullptr, F.X(), F.X(), GATE(modL + 2 * DM)};
              pg8::gemm_phase<pg8::EpiResGateB16, pg8::StaticOrder, true, true>(F.lds, g, S, E, F.tid); }
            if (!lastL) { int r0, r1; share(MLAT, MALL, F.bid, F.G, r0, r1); norm_range(F, L, 1, r0, r1); }
            REP_SYNC(); }
            SEAM(pb + 4);
        }

        if (((PH_MASK >> 6) & 1) && IN(pb + 5)) { REPS(6) { PHASE_BEGIN();
            int r0, r1;
            if (!lastL) { pg8::Gemm g{F.HX(), (const bf16*)((const char*)wt + WT_UP), MCTX, FU, DM}; OffOrder S; S.init(MCTX, FU, F.G, F.bid); S.pm0 = 64;
              pg8::EpiBf16<0> E{F.U(), FU, nullptr, 0, 0, 1.f};
              pg8::gemm_phase<pg8::EpiBf16<0>, OffOrder, true, true>(F.lds, g, S, E, F.tid);
              if (G256) { if (F.bid < 88) { r0 = 0; r1 = 0; } else share(0, MLAT, F.bid - 88, 168, r0, r1); } else share(0, MLAT, F.bid, F.G, r0, r1); }
            else share(0, MLAT, F.bid, F.G, r0, r1);
            norm_range(F, L, 1, r0, r1);
            REP_SYNC(); }
            SEAM(pb + 5);
        }

        if (((PH_MASK >> 7) & 1) && IN(pb + 6)) { REPS(7) { PHASE_BEGIN();
            { pg8::Gemm g{F.HX(), (const bf16*)((const char*)wt + WT_UP), MLAT, FU, DM}; pg8::StaticOrder S; S.init(MLAT, FU, F.G, F.bid);
              pg8::EpiBf16<0> E{F.U(), FU, nullptr, 0, 0, 1.f};
              pg8::gemm_phase<pg8::EpiBf16<0>, pg8::StaticOrder, true, true>(F.lds, g, S, E, F.tid); }
            if (!lastL) { if (G256) convgate_phase(F, L, MLAT, MALL, 192, 64); else convgate_phase(F, L, MLAT, MALL, 0, F.G); }
            REP_SYNC(); }
            SEAM(pb + 6);
        }

        if (((PH_MASK >> 8) & 1) && IN(pb + 7)) { REPS(8) { PHASE_BEGIN();
            if (!lastL) { pg8::Gemm g{F.ACT(), (const bf16*)((const char*)wt + WT_DN), MCTX, DM, FH}; OffOrder S; S.init(MCTX, DM, F.G, F.bid); S.pm0 = 64;
              pg8::EpiResGateB16 E{nullptr, nullptr, F.X(), F.X(), GATE(modL + 5 * DM)};
              pg8::gemm_phase<pg8::EpiResGateB16, OffOrder, true, true>(F.lds, g, S, E, F.tid); }
            SUBREPS(3) { if (G256 && !lastL) convgate_phase(F, L, 0, MLAT, 64, 192); else convgate_phase(F, L, 0, MLAT, 0, F.G); }
            REP_SYNC(); }
            SEAM(pb + 7);
        }

        if (((PH_MASK >> 9) & 1) && IN(pb + 8)) { REPS(9) { PHASE_BEGIN();
            { pg8::Gemm g{F.ACT(), (const bf16*)((const char*)wt + WT_DN), MLAT, DM, FH}; pg8::StaticOrder S; S.init(MLAT, DM, F.G, F.bid);
              pg8::EpiResGateB16 E{nullptr, nullptr, F.X(), F.X(), GATE(modL + 5 * DM)};
              pg8::gemm_phase<pg8::EpiResGateB16, pg8::StaticOrder, true, true>(F.lds, g, S, E, F.tid); }
            if (!lastL) { int r0, r1; share(MLAT, MALL, F.bid, F.G, r0, r1); norm_range(F, L + 1, 0, r0, r1); }
            REP_SYNC(); }
            SEAM(pb + 8);
        }
    }
    if (((PH_MASK >> 10) & 1) && IN(NPH - 1)) { PHASE_BEGIN(); final_norm_phase(F); }
#ifdef EXTRA_BARS
    if (!MK_PER_PHASE) for (int eb = 0; eb < EXTRA_BARS; ++eb) xcd_barrier(bar, F.tid);
#endif
#undef IN
#undef SEAM
}

extern "C" void kernel_launch(void* const* d_in, const int* in_sizes, int n_in, void* d_out, int out_size, void* d_ws, size_t ws_size, hipStream_t stream) {
    static int grid = 0;
    if (grid == 0) {
        if (n_in != 25 || out_size != MLAT * DM || ws_size < WS_END) { fprintf(stderr, "kernel_launch: unexpected shapes (n_in %d, out %d, ws %zu)\n", n_in, out_size, ws_size); grid = -1; return; }
        int dev = 0, cus = 0, per_cu = 0;
        if (hipGetDevice(&dev) != hipSuccess || hipDeviceGetAttribute(&cus, hipDeviceAttributeMultiprocessorCount, dev) != hipSuccess) { grid = -1; return; }
        if (hipFuncSetAttribute((const void*)fwd_kernel, hipFuncAttributeMaxDynamicSharedMemorySize, LDS_BYTES) != hipSuccess) { fprintf(stderr, "kernel_launch: hipFuncSetAttribute failed\n"); grid = -1; return; }
        if (hipOccupancyMaxActiveBlocksPerMultiprocessor(&per_cu, (const void*)fwd_kernel, NTHREADS, LDS_BYTES) != hipSuccess || per_cu < 1) { fprintf(stderr, "kernel_launch: occupancy query says %d\n", per_cu); }
        (void)hipGetLastError();
        grid = cus;
    }
    if (grid < 0) return;
    if (hipMemsetAsync((char*)d_ws + WS_CTL, 0, CTL_ZERO_BYTES, stream) != hipSuccess) return;
    Args a{};
    for (int i = 0; i < 25; ++i) a.in[i] = (const float*)d_in[i];
    a.out = (float*)d_out; a.ws = (unsigned char*)d_ws;
#if MK_PER_PHASE
    for (int p = 0; p < NPH; ++p) { a.ph_lo = p; a.ph_hi = p + 1; hipLaunchKernelGGL(fwd_kernel, dim3(grid), dim3(NTHREADS), LDS_BYTES, stream, a); }
#else
    a.ph_lo = 0; a.ph_hi = NPH;
    hipLaunchKernelGGL(fwd_kernel, dim3(grid), dim3(NTHREADS), LDS_BYTES, stream, a);
#endif
    const hipError_t le = hipPeekAtLastError();
    if (le != hipSuccess) fprintf(stderr, "kernel_launch: launch failed: %s\n", hipGetErrorName(le));
}
```

```cpp
#include <hip/hip_runtime.h>
#include <cstdio>
#include <cstdint>
namespace pg8 {
#define PG8_LAS __attribute__((address_space(3)))
typedef unsigned short bf16_t;
typedef short bf16x8 __attribute__((ext_vector_type(8)));
typedef float f32x4 __attribute__((ext_vector_type(4)));
typedef unsigned u32x4 __attribute__((ext_vector_type(4)));
constexpr int BM = 256, BK = 64, HALF = 128, HTB = HALF * BK * 2  , STAGE_BYTES = 8 * HTB, NXCD = 8, WGM = 8;

__host__ __device__ __forceinline__ int lds_byte(int r, int c) { const int st = (r >> 4) * 2 + (c >> 5), rr = r & 15, cc = c & 31, ob = rr * 64 + cc * 2; return st * 1024 + (ob ^ (((ob >> 9) & 1) << 5)); }
__host__ __device__ __forceinline__ void stage_rc(int b, int& R, int& C) { const int st = b / 1024, sb = b % 1024, swz = sb ^ (((sb >> 9) & 1) << 5); R = (st >> 1) * 16 + swz / 64; C = (st & 1) * 32 + (swz % 64) / 2; }
__host__ __device__ __forceinline__ int perm32(int rho) { const int n = rho >> 4, i = rho & 15; return 8 * (i >> 2) + 4 * n + (i & 3); }

struct Unit { int pm, pn; };
struct Gemm { const bf16_t* A; const bf16_t* Bt; int M, N, K; };

struct StaticOrder {
    int nM, nN, nwg, G, c;
    __host__ __device__ void init(int M, int N, int G_, int c_) { nM = M / BM; nN = N / BM; nwg = nM * nN; G = G_; c = c_; }
    __host__ __device__ bool next(int i, Unit& u) const {
        const long L = (long)i * G + c; if (L >= nwg) return false;
        int wgid = (int)L; { const int q = nwg / NXCD, r = nwg % NXCD, xcd = wgid % NXCD, off = wgid / NXCD; wgid = (xcd < r ? xcd * (q + 1) : r * (q + 1) + (xcd - r) * q) + off; }
        const int nig = WGM * nN, gid = wgid / nig, fm = gid * WGM, gsz = (nM - fm) < WGM ? (nM - fm) : WGM;
        u.pm = fm + ((wgid % nig) % gsz); u.pn = (wgid % nig) / gsz; return true;
    }
    __device__ __forceinline__ void a_ready(const Unit&) const {}
    __device__ __forceinline__ void done(const Unit&) const {}
};

__device__ __forceinline__ unsigned cvt_pk_bf16(float lo, float hi) { unsigned r; asm volatile("v_cvt_pk_bf16_f32 %0, %1, %2" : "=v"(r) : "v"(lo), "v"(hi)); return r; }
typedef float f32x2 __attribute__((ext_vector_type(2)));
__device__ __forceinline__ f32x2 gelu_pk(f32x2 v) {
    const f32x2 av = __builtin_elementwise_abs(v), d = av * 0.2316418882f + 1.0f;
    f32x2 t; t.x = __builtin_amdgcn_rcpf(d.x); t.y = __builtin_amdgcn_rcpf(d.y);
    f32x2 q = t * 0.5307027145f + (-0.7265760135f); q = q * t + 0.7107068705f; q = q * t + (-0.142248368f); q = q * t + 0.127414796f; q = q * t;
    const f32x2 s = (v * v) * (-0.72134752044f);
    f32x2 e; e.x = __builtin_amdgcn_exp2f(s.x); e.y = __builtin_amdgcn_exp2f(s.y);
    const f32x2 m = v * (q * e), r = v - m;
    f32x2 o; o.x = v.x < 0.f ? m.x : r.x; o.y = v.y < 0.f ? m.y : r.y; return o;
}

template <int ACT  > struct EpiBf16 {
    static constexpr bool PERM = true, AFTER_DRAIN = false; static_assert(ACT == 0 || ACT == 1, "EpiBf16: ACT is 0 (none) or 1 (gelu_pk)");
    bf16_t* O; int ldc; const float* bias; int split_cols; size_t split_stride; float scale0;
    __device__ __forceinline__ void operator()(const f32x4 (&acc)[2][2][4][2], const Unit& u, int wr, int wc, int fr, int fq) const {
        const int row0 = u.pm * BM + wr * 64 + fr; int colt = u.pn * BM; bf16_t* base = O;
        float sc = 1.f; if (split_cols) { const int t = colt / split_cols; base += (size_t)t * split_stride; colt -= t * split_cols; if (t == 0) sc = scale0; }
        const int col0 = colt + wc * 32 + 8 * fq, bcol0 = u.pn * BM + wc * 32 + 8 * fq;
        f32x4 bv[2][2];
#pragma unroll
        for (int bj = 0; bj < 2; ++bj)
#pragma unroll
            for (int n = 0; n < 2; ++n) bv[bj][n] = bias ? *(const f32x4*)(bias + bcol0 + bj * HALF + 4 * n) : (f32x4){0.f, 0.f, 0.f, 0.f};
#pragma unroll
        for (int ai = 0; ai < 2; ++ai)
#pragma unroll
            for (int m = 0; m < 4; ++m) { bf16_t* rowp = base + (size_t)(row0 + ai * HALF + m * 16) * ldc + col0;
#pragma unroll
                for (int bj = 0; bj < 2; ++bj) { f32x4 v0 = acc[ai][bj][m][0] + bv[bj][0], v1 = acc[ai][bj][m][1] + bv[bj][1];
                    if (ACT == 1) { f32x2 a = gelu_pk((f32x2){v0[0], v0[1]}), b = gelu_pk((f32x2){v0[2], v0[3]}), c = gelu_pk((f32x2){v1[0], v1[1]}), d = gelu_pk((f32x2){v1[2], v1[3]});
                        v0 = (f32x4){a.x, a.y, b.x, b.y}; v1 = (f32x4){c.x, c.y, d.x, d.y}; }
                    v0 = v0 * sc; v1 = v1 * sc; u32x4 w; w.x = cvt_pk_bf16(v0[0], v0[1]); w.y = cvt_pk_bf16(v0[2], v0[3]); w.z = cvt_pk_bf16(v1[0], v1[1]); w.w = cvt_pk_bf16(v1[2], v1[3]);
                    *(u32x4*)(rowp + bj * HALF) = w; } }
    }
};

struct EpiResGate {
    static constexpr bool PERM = false, AFTER_DRAIN = false;
    const float* base_lat; const float* base_ctx;
    float* out; const float* gate;
    __device__ __forceinline__ void operator()(const f32x4 (&acc)[2][2][4][2], const Unit& u, int wr, int wc, int fr, int fq) const {
        const int row0 = u.pm * BM + wr * 64 + fr, col0 = u.pn * BM + wc * 32 + 4 * fq;
        const int v = u.pm < 64 ? (u.pm >> 3) : 8;
        const float* gp = gate + (size_t)v * 12288 + col0;
        const float* base = u.pm < 64 ? base_lat : base_ctx;
        f32x4 gv[2][2];
#pragma unroll
        for (int bj = 0; bj < 2; ++bj)
#pragma unroll
            for (int n = 0; n < 2; ++n) gv[bj][n] = *(const f32x4*)(gp + bj * HALF + n * 16);
#pragma unroll
        for (int ai = 0; ai < 2; ++ai)
#pragma unroll
            for (int m = 0; m < 4; ++m) { const size_t off = (size_t)(row0 + ai * HALF + m * 16) * 2048 + col0;
#pragma unroll
                for (int bj = 0; bj < 2; ++bj)
#pragma unroll
                    for (int n = 0; n < 2; ++n) { const f32x4 b = *(const f32x4*)(base + off + bj * HALF + n * 16);
                        *(f32x4*)(out + off + bj * HALF + n * 16) = b + gv[bj][n] * acc[ai][bj][m][n]; } }
    }
};

struct EpiResGateB16 {
    static constexpr bool PERM = true, AFTER_DRAIN = false;
    const float* base32_lat; const float* base32_ctx;
    const bf16_t* base16; bf16_t* out; const float* gate;
    __device__ __forceinline__ void operator()(const f32x4 (&acc)[2][2][4][2], const Unit& u, int wr, int wc, int fr, int fq) const {
        const int row0 = u.pm * BM + wr * 64 + fr, col0 = u.pn * BM + wc * 32 + 8 * fq;
        const int v = u.pm < 64 ? (u.pm >> 3) : 8;
        const float* gp = gate + (size_t)v * 12288 + col0;
        const float* b32 = u.pm < 64 ? base32_lat : base32_ctx;
        f32x4 gv[2][2];
#pragma unroll
        for (int bj = 0; bj < 2; ++bj)
#pragma unroll
            for (int n = 0; n < 2; ++n) gv[bj][n] = *(const f32x4*)(gp + bj * HALF + 4 * n);
#pragma unroll
        for (int ai = 0; ai < 2; ++ai)
#pragma unroll
            for (int m = 0; m < 4; ++m) { const size_t off = (size_t)(row0 + ai * HALF + m * 16) * 2048 + col0;
#pragma unroll
                for (int bj = 0; bj < 2; ++bj) {
                    f32x4 b0, b1;
                    if (b32) { b0 = *(const f32x4*)(b32 + off + bj * HALF); b1 = *(const f32x4*)(b32 + off + bj * HALF + 4); }
                    else { const u32x4 w = *(const u32x4*)(base16 + off + bj * HALF);
                        b0 = (f32x4){__builtin_bit_cast(float, w.x << 16), __builtin_bit_cast(float, w.x & 0xffff0000u), __builtin_bit_cast(float, w.y << 16), __builtin_bit_cast(float, w.y & 0xffff0000u)};
                        b1 = (f32x4){__builtin_bit_cast(float, w.z << 16), __builtin_bit_cast(float, w.z & 0xffff0000u), __builtin_bit_cast(float, w.w << 16), __builtin_bit_cast(float, w.w & 0xffff0000u)}; }
                    const f32x4 v0 = b0 + gv[bj][0] * acc[ai][bj][m][0], v1 = b1 + gv[bj][1] * acc[ai][bj][m][1];
                    u32x4 o; o.x = cvt_pk_bf16(v0[0], v0[1]); o.y = cvt_pk_bf16(v0[2], v0[3]); o.z = cvt_pk_bf16(v1[0], v1[1]); o.w = cvt_pk_bf16(v1[2], v1[3]);
                    *(u32x4*)(out + off + bj * HALF) = o; } }
    }
};
struct EpiInSplit {
    static constexpr bool PERM = true, AFTER_DRAIN = false;
    bf16_t* Z; int ldz; bf16_t* QH; bf16_t* KH; bf16_t* VH;
    int row_base, T;
    __device__ __forceinline__ void operator()(const f32x4 (&acc)[2][2][4][2], const Unit& u, int wr, int wc, int fr, int fq) const {
        const int row0 = u.pm * BM + wr * 64 + fr, colt = u.pn * BM, blk = colt >> 10;
        const bool hm = blk == 2 || blk == 3 || (blk == 1 && QH != nullptr);
        bf16_t* dst = !hm ? Z : (blk == 1 ? QH : (blk == 2 ? KH : VH));
        const __amdgpu_buffer_rsrc_t rs = __builtin_amdgcn_make_buffer_rsrc(dst, 0, 0x7fffffff, 0x00020000);
        const unsigned uT = (unsigned)T, tsh = T == 2048 ? 11u : 8u;
        const unsigned lane_hm = ((unsigned)(((colt & 1023) >> 6) + (wc >> 1)) * uT * 64u + (unsigned)((wc & 1) * 32 + 8 * fq)) * 2u, step_hm = 2u * uT * 64u * 2u;
        const unsigned lane_rm = (unsigned)(colt + wc * 32 + 8 * fq) * 2u, step_rm = (unsigned)HALF * 2u;
        const unsigned lane_off = hm ? lane_hm : lane_rm, step = hm ? step_hm : step_rm;
#pragma unroll
        for (int ai = 0; ai < 2; ++ai)
#pragma unroll
            for (int m = 0; m < 4; ++m) { const unsigned row = (unsigned)(row0 + ai * HALF + m * 16), rl = row - (unsigned)row_base;
                const unsigned rowb = hm ? ((rl >> tsh) * 16u * uT + (rl & (uT - 1u))) * 128u : row * (unsigned)ldz * 2u;
#pragma unroll
                for (int bj = 0; bj < 2; ++bj) { const f32x4 v0 = acc[ai][bj][m][0], v1 = acc[ai][bj][m][1];
                    u32x4 w; w.x = cvt_pk_bf16(v0[0], v0[1]); w.y = cvt_pk_bf16(v0[2], v0[3]); w.z = cvt_pk_bf16(v1[0], v1[1]); w.w = cvt_pk_bf16(v1[2], v1[3]);
                    __builtin_amdgcn_raw_buffer_store_b128(w, rs, (int)(rowb + lane_off + (unsigned)bj * step), 0, 0); } }
    }
};

template <class Epi, class Sched, bool ALIGN_EPI = false, bool SP2 = false>
__device__ __forceinline__ void gemm_phase(PG8_LAS unsigned char* lds, const Gemm g, const Sched& S, const Epi& E, int tid_in) {
    int tid_ = tid_in; asm volatile("" : "+v"(tid_));
    const int tid = tid_, wid = __builtin_amdgcn_readfirstlane(tid >> 6), lane = tid & 63, wr = wid >> 2, wc = wid & 3, fr = lane & 15, fq = lane >> 4;
    const int K = g.K, nt = K / BK;
    unsigned voffA[2], voffB[2];
#pragma unroll
    for (int i = 0; i < 2; ++i) { int R, C; stage_rc(tid * 16 + i * 8192, R, C); const int Rb = Epi::PERM ? ((R & ~31) + perm32(R & 31)) : R;
        voffA[i] = (unsigned)(R * K + C) * 2u; voffB[i] = (unsigned)(Rb * K + C) * 2u; }
    const size_t kstep = (size_t)(BK * 2);
    const size_t hstep = (size_t)HALF * K * 2;
    const size_t tstep = 2 * hstep;
    const unsigned ldsw = (unsigned)wid * 1024u;
    const int aoff = lds_byte(wr * 64 + fr, fq * 8), boff = lds_byte(wc * 32 + fr, fq * 8);
#define PG8_SA(b, h) (((b) * 2 + (h)) * HTB)
#define PG8_SB(b, h) ((4 + (b) * 2 + (h)) * HTB)
#define PG8_STAGE(bufoff, gbase, voff) do { _Pragma("unroll") for (int _i = 0; _i < 2; ++_i) \
        __builtin_amdgcn_global_load_lds((const unsigned*)((const char*)(gbase) + (voff)[_i]), (PG8_LAS unsigned*)(lds + (bufoff) + ldsw + _i * 8192), 16, 0, 0); } while (0)
#define PG8_LDA(dst, b, h) do { _Pragma("unroll") for (int m = 0; m < 4; ++m) _Pragma("unroll") for (int k = 0; k < 2; ++k) dst[m][k] = *(const PG8_LAS bf16x8*)(lds + PG8_SA(b, h) + aoff + m * 2048 + k * 1024); } while (0)
#define PG8_LDB(dst, b, h) do { _Pragma("unroll") for (int n = 0; n < 2; ++n) _Pragma("unroll") for (int k = 0; k < 2; ++k) dst[n][k] = *(const PG8_LAS bf16x8*)(lds + PG8_SB(b, h) + boff + n * 2048 + k * 1024); } while (0)
#define PG8_MMA(ai, bj, At, Bt) do { __builtin_amdgcn_s_setprio(1); _Pragma("unroll") for (int m = 0; m < 4; ++m) _Pragma("unroll") for (int n = 0; n < 2; ++n) _Pragma("unroll") for (int k = 0; k < 2; ++k) \
        acc[ai][bj][m][n] = __builtin_amdgcn_mfma_f32_16x16x32_bf16(Bt[n][k], At[m][k], acc[ai][bj][m][n], 0, 0, 0); __builtin_amdgcn_s_setprio(0); } while (0)
#define PG8_WAIT_V(n) asm volatile("s_waitcnt vmcnt(" #n ")" ::: "memory")
#define PG8_WAIT_L(n) asm volatile("s_waitcnt lgkmcnt(" #n ")" ::: "memory")
#define PG8_BAR __builtin_amdgcn_s_barrier()
#define PG8_SCHED __builtin_amdgcn_sched_barrier(0)
    Unit cur, nxt; int ui = 0;
    if (!S.next(0, cur)) return;
    f32x4 acc[2][2][4][2];
#pragma unroll
    for (int a = 0; a < 2; ++a)
#pragma unroll
        for (int b = 0; b < 2; ++b)
#pragma unroll
            for (int m = 0; m < 4; ++m)
#pragma unroll
                for (int n = 0; n < 2; ++n) acc[a][b][m][n] = (f32x4){0.f, 0.f, 0.f, 0.f};
    bf16x8 At[4][2], B0[2][2], B1[2][2];
    const char* cA = (const char*)g.A + (size_t)cur.pm * tstep; const char* cB = (const char*)g.Bt + (size_t)cur.pn * tstep;
    S.a_ready(cur);
    if constexpr (SP2) {
        PG8_STAGE(PG8_SB(0, 0), cB, voffB); PG8_STAGE(PG8_SB(0, 1), cB + hstep, voffB); PG8_STAGE(PG8_SA(0, 0), cA, voffA); PG8_STAGE(PG8_SA(0, 1), cA + hstep, voffA);
        if (wr == 1) PG8_BAR;
        PG8_WAIT_V(2); PG8_BAR;
        PG8_STAGE(PG8_SB(1, 0), cB + kstep, voffB); PG8_STAGE(PG8_SA(1, 0), cA + kstep, voffA); PG8_STAGE(PG8_SB(1, 1), cB + hstep + kstep, voffB);
        PG8_WAIT_V(6); PG8_BAR;
    } else {
        PG8_STAGE(PG8_SB(0, 0), cB, voffB); PG8_STAGE(PG8_SA(0, 0), cA, voffA); PG8_STAGE(PG8_SB(0, 1), cB + hstep, voffB); PG8_STAGE(PG8_SA(0, 1), cA + hstep, voffA);
        if (wr == 1) PG8_BAR;
        PG8_WAIT_V(4); PG8_BAR;
        PG8_STAGE(PG8_SB(1, 0), cB + kstep, voffB); PG8_STAGE(PG8_SA(1, 0), cA + kstep, voffA); PG8_STAGE(PG8_SB(1, 1), cB + hstep + kstep, voffB);
        PG8_WAIT_V(6); PG8_BAR;
    }
    for (;;) {
        const bool has_next = S.next(ui + 1, nxt);
        const char* nA = has_next ? (const char*)g.A + (size_t)nxt.pm * tstep : cA; const char* nB = has_next ? (const char*)g.Bt + (size_t)nxt.pn * tstep : cB;
        for (int t = 0; t < nt; t += 2) {
            const bool last = (t == nt - 2);
            const char* a1 = cA + (size_t)(t + 1) * kstep;
            const char* a2 = last ? nA : cA + (size_t)(t + 2) * kstep; const char* b2 = last ? nB : cB + (size_t)(t + 2) * kstep;
            const char* a3 = a2 + kstep; const char* b3 = b2 + kstep;
            if (last && has_next) S.a_ready(nxt);
            if constexpr (SP2) {
            PG8_LDB(B0, 0, 0); PG8_LDB(B1, 0, 1); PG8_SCHED; PG8_LDA(At, 0, 0); PG8_STAGE(PG8_SA(1, 1), a1 + hstep, voffA);
            PG8_WAIT_V(8); PG8_WAIT_L(0); PG8_BAR; PG8_MMA(0, 0, At, B0); PG8_MMA(0, 1, At, B1); PG8_BAR; PG8_SCHED;
            PG8_LDA(At, 0, 1); PG8_STAGE(PG8_SB(0, 0), b2, voffB); PG8_STAGE(PG8_SB(0, 1), b2 + hstep, voffB); PG8_STAGE(PG8_SA(0, 0), a2, voffA);
            PG8_WAIT_V(8); PG8_WAIT_L(0); PG8_BAR; PG8_MMA(1, 0, At, B0); PG8_MMA(1, 1, At, B1); PG8_BAR; PG8_SCHED;
            PG8_LDB(B0, 1, 0); PG8_LDB(B1, 1, 1); PG8_SCHED; PG8_LDA(At, 1, 0); PG8_STAGE(PG8_SA(0, 1), a2 + hstep, voffA);
            PG8_WAIT_V(8); PG8_WAIT_L(0); PG8_BAR; PG8_MMA(0, 0, At, B0); PG8_MMA(0, 1, At, B1); PG8_BAR; PG8_SCHED;
            PG8_LDA(At, 1, 1); PG8_STAGE(PG8_SB(1, 0), b3, voffB); PG8_STAGE(PG8_SB(1, 1), b3 + hstep, voffB); PG8_STAGE(PG8_SA(1, 0), a3, voffA);
            PG8_WAIT_V(8); PG8_WAIT_L(0); PG8_BAR; PG8_MMA(1, 0, At, B0); PG8_MMA(1, 1, At, B1); PG8_BAR; PG8_SCHED;
            } else {
            PG8_LDB(B0, 0, 0); PG8_SCHED; PG8_LDA(At, 0, 0); PG8_STAGE(PG8_SA(1, 1), a1 + hstep, voffA);
            PG8_WAIT_L(8); PG8_BAR; PG8_WAIT_L(0); PG8_MMA(0, 0, At, B0); PG8_BAR; PG8_SCHED;
            PG8_LDB(B1, 0, 1); PG8_STAGE(PG8_SB(0, 0), b2, voffB);
            PG8_BAR; PG8_WAIT_L(0); PG8_MMA(0, 1, At, B1); PG8_BAR;
            PG8_LDA(At, 0, 1); PG8_STAGE(PG8_SA(0, 0), a2, voffA);
            PG8_BAR; PG8_WAIT_L(0); PG8_MMA(1, 0, At, B0); PG8_BAR; PG8_SCHED;
            PG8_STAGE(PG8_SB(0, 1), b2 + hstep, voffB);
            PG8_WAIT_V(6); PG8_BAR; PG8_MMA(1, 1, At, B1); PG8_BAR;
            PG8_LDB(B0, 1, 0); PG8_SCHED; PG8_LDA(At, 1, 0); PG8_STAGE(PG8_SA(0, 1), a2 + hstep, voffA);
            PG8_WAIT_L(8); PG8_BAR; PG8_WAIT_L(0); PG8_MMA(0, 0, At, B0); PG8_BAR; PG8_SCHED;
            PG8_LDB(B1, 1, 1); PG8_STAGE(PG8_SB(1, 0), b3, voffB);
            PG8_BAR; PG8_WAIT_L(0); PG8_MMA(0, 1, At, B1); PG8_BAR;
            PG8_LDA(At, 1, 1); PG8_STAGE(PG8_SA(1, 0), a3, voffA);
            PG8_BAR; PG8_WAIT_L(0); PG8_MMA(1, 0, At, B0); PG8_BAR; PG8_SCHED;
            PG8_STAGE(PG8_SB(1, 1), b3 + hstep, voffB);
            PG8_WAIT_V(6); PG8_BAR; PG8_MMA(1, 1, At, B1); PG8_BAR;
            }
        }
        if constexpr (ALIGN_EPI) { if (wr == 0) PG8_BAR; }
        if constexpr (!Epi::AFTER_DRAIN) { E(acc, cur, wr, wc, fr, fq); S.done(cur); }
        if (!has_next) break;
#pragma unroll
        for (int a = 0; a < 2; ++a)
#pragma unroll
            for (int b = 0; b < 2; ++b)
#pragma unroll
                for (int m = 0; m < 4; ++m)
#pragma unroll
                    for (int n = 0; n < 2; ++n) acc[a][b][m][n] = (f32x4){0.f, 0.f, 0.f, 0.f};
        cur = nxt; cA = nA; cB = nB; ++ui;
        if constexpr (ALIGN_EPI) { if (wr == 1) PG8_BAR; }
    }
    PG8_WAIT_V(0);
    if constexpr (!ALIGN_EPI) { if (wr == 0) PG8_BAR; }
    PG8_BAR;
    if constexpr (Epi::AFTER_DRAIN) { E.fused(acc, cur, wr, wc, fr, fq, lds, wid, lane); S.done(cur); }
#undef PG8_SA
#undef PG8_SB
#undef PG8_STAGE
#undef PG8_LDA
#undef PG8_LDB
#undef PG8_MMA
#undef PG8_WAIT_V
#undef PG8_WAIT_L
#undef PG8_BAR
#undef PG8_SCHED
}
}

constexpr int NWAVES = 8, NTHREADS = 512;
constexpr int NB = 8, SEQ = 2048, DM = 2048, DEPTH = 4, CTXL = 256;
constexpr int MLAT = NB * SEQ, MCTX = NB * CTXL, MALL = MLAT + MCTX;
constexpr int PW = 5120, FH = 5504, FU = 2 * FH, NH = 16, MODW = 6 * DM;
constexpr int ZC_AX = 0, ZC_AY = 512, ZC_Q = 1024, ZC_K = 2048, ZC_V = 3072, ZC_SU = 4096, ZC_SV = 4608;
constexpr float NORM_EPS = 1e-6f;
constexpr int NCHUNK = MALL / 64;

constexpr size_t MiB = 1u << 20;
constexpr size_t WS_CTL = 0, CTL_ZERO_BYTES = 1 * MiB;
constexpr size_t WS_MOD = 1 * MiB;
constexpr size_t WS_GWT = 3 * MiB;
constexpr size_t WS_SWB = 4 * MiB;
constexpr size_t WS_AGG = 5 * MiB;
constexpr size_t WS_ROPE = 7 * MiB + 512 * 1024;
constexpr size_t WS_AGT = 1288 * MiB;
constexpr size_t WS_WT = 8 * MiB;
constexpr size_t WT_IN = 0, WT_OUT = (size_t)PW * DM * 2, WT_UP = WT_OUT + (size_t)DM * DM * 2, WT_DN = WT_UP + (size_t)FU * DM * 2, WT_LAYER = WT_DN + (size_t)DM * FH * 2;
static_assert(WT_LAYER == 96993280, "weights per layer");
constexpr size_t WS_X = 378 * MiB;
constexpr size_t WS_HX = 522 * MiB;
constexpr size_t WS_ACT = 594 * MiB;
constexpr size_t WS_R1 = 788 * MiB;
constexpr size_t WS_Z = WS_R1;
constexpr size_t WS_MIX = WS_R1 + 180 * MiB;
constexpr size_t WS_AB = WS_R1 + 252 * MiB;
constexpr size_t WS_U = WS_R1;
constexpr size_t WS_QR = 1184 * MiB, WS_KR = 1216 * MiB, WS_VT = 1248 * MiB, WS_KC = 1280 * MiB, WS_VTC = 1284 * MiB, WS_END = 1298 * MiB;
static_assert(WS_WT + 4 * WT_LAYER <= WS_X && WS_ACT + (size_t)MALL * FH * 2 <= WS_R1 && WS_U + (size_t)MALL * FU * 2 <= WS_QR && WS_AB + (size_t)4 * MALL * 512 * 4 <= WS_QR, "d_ws map");
constexpr int CW_BAR = 4096;
constexpr int CW_Q = 8192;

constexpr int RING_BYTES = 131072;
constexpr int MISC_OFF = 144 * 1024 - 128;
constexpr int PTR_OFF = 144 * 1024 - 512;
constexpr int LDS_BYTES = 147456;

#define GAS __attribute__((address_space(1)))
#define LAS __attribute__((address_space(3)))
typedef unsigned short bf16;
typedef unsigned v4u __attribute__((ext_vector_type(4)));
typedef unsigned v2u __attribute__((ext_vector_type(2)));
typedef float f32x4 __attribute__((ext_vector_type(4)));
typedef short bf16x8 __attribute__((ext_vector_type(8)));
__device__ __forceinline__ unsigned f2bf(float f) { unsigned u = __builtin_bit_cast(unsigned, f); return (u + 0x7fffu + ((u >> 16) & 1u)) >> 16; }
typedef float f32x2_t __attribute__((ext_vector_type(2))); typedef __bf16 bf16x2_t __attribute__((ext_vector_type(2)));
__device__ __forceinline__ unsigned pk2(float lo, float hi) { f32x2_t v = {lo, hi}; bf16x2_t b = __builtin_convertvector(v, bf16x2_t); return __builtin_bit_cast(unsigned, b); }
__device__ __forceinline__ float bflo(unsigned w) { return __builtin_bit_cast(float, w << 16); }
__device__ __forceinline__ float bfhi(unsigned w) { return __builtin_bit_cast(float, w & 0xffff0000u); }
__device__ __forceinline__ float bf1(bf16 h) { return __builtin_bit_cast(float, (unsigned)h << 16); }
__device__ __forceinline__ void unpack8(v4u w, float (&x)[8]) { x[0] = bflo(w.x); x[1] = bfhi(w.x); x[2] = bflo(w.y); x[3] = bfhi(w.y); x[4] = bflo(w.z); x[5] = bfhi(w.z); x[6] = bflo(w.w); x[7] = bfhi(w.w); }
__device__ __forceinline__ v4u pack8(const float (&x)[8]) { v4u w; w.x = pk2(x[0], x[1]); w.y = pk2(x[2], x[3]); w.z = pk2(x[4], x[5]); w.w = pk2(x[6], x[7]); return w; }
__device__ __forceinline__ float sigm(float x) { return __builtin_amdgcn_rcpf(1.f + __expf(-x)); }
__device__ __forceinline__ float silu_f(float x) { return x * __builtin_amdgcn_rcpf(1.f + __expf(-x)); }
__device__ __forceinline__ float gelu_t(float x) { const float u = 0.7978845608028654f * (x + 0.044715f * x * x * x); return x * __builtin_amdgcn_rcpf(1.f + __expf(-2.f * u)); }
__device__ __forceinline__ float shx(float v, int mask, int lane) { return __builtin_bit_cast(float, __builtin_amdgcn_ds_bpermute((lane ^ mask) << 2, __builtin_bit_cast(int, v))); }
__device__ __forceinline__ unsigned shxu(unsigned v, int mask, int lane) { return (unsigned)__builtin_amdgcn_ds_bpermute((lane ^ mask) << 2, (int)v); }
__device__ __forceinline__ float wave_sum(float v, int lane) {
#pragma unroll
    for (int o = 1; o < 64; o <<= 1) v += shx(v, o, lane);
    return v;
}
#define LDS_WAIT() asm volatile("s_waitcnt lgkmcnt(0)" ::: "memory")
__device__ __forceinline__ f32x4 mfma16(bf16x8 a, bf16x8 b, f32x4 c) { return __builtin_amdgcn_mfma_f32_16x16x32_bf16(a, b, c, 0, 0, 0); }
__device__ __forceinline__ bf16x8 ldfrag(const bf16* p) { return *(const bf16x8*)p; }
#define XB_TMO      128
#define XB_XCNT(j)  (256  + 64 * (j))
#define XB_XSUB(j)  (1280 + 64 * (j))
#define XB_XGEN(j)  (2304 + 64 * (j))
#define XB_TOP      3328
#define XB_TOPGEN   3392
#define XCD_BAR_WORDS 3456
#define XB_SPIN_CAP (1u << 18)

__device__ __forceinline__ unsigned xb_ld(unsigned* p)              { return __hip_atomic_load(p, __ATOMIC_RELAXED, __HIP_MEMORY_SCOPE_AGENT); }
__device__ __forceinline__ unsigned xb_add(unsigned* p, unsigned v) { return __hip_atomic_fetch_add(p, v, __ATOMIC_RELAXED, __HIP_MEMORY_SCOPE_AGENT); }
__device__ __forceinline__ unsigned xb_xcc_id() { return (unsigned)__builtin_amdgcn_s_getreg((3 << 11) | 20) & 0xFu; }
#define XB_SPIN(cond, bar) do { unsigned _sp = 0; while (cond) { __builtin_amdgcn_s_sleep(1); \
    if ((++_sp & 255u) == 0u) { if (xb_ld(&(bar)[XB_TMO])) break; if (_sp > XB_SPIN_CAP) { atomicAdd(&(bar)[XB_TMO], 1u); break; } } } } while (0)

struct XcdBarrier {
    unsigned* bar; unsigned x;
    volatile LAS unsigned* st;
};

__device__ __forceinline__ XcdBarrier xcd_barrier_post(unsigned* bar, volatile LAS unsigned* st) {
    XcdBarrier b; b.bar = bar; b.x = xb_xcc_id(); b.st = st;
    if (threadIdx.x == 0) (void)xb_add(&bar[XB_XCNT(b.x)], 1u);
    return b;
}
__device__ __forceinline__ void xcd_barrier_complete(unsigned* bar, unsigned x, unsigned& nloc, unsigned& nx) {
    const unsigned G = gridDim.x * gridDim.y * gridDim.z;
    unsigned sum, cnt, mine, sp = 0u;
    for (;;) {
        sum = 0u; cnt = 0u; mine = 0u;
#pragma unroll
        for (unsigned j = 0; j < 16; ++j) { const unsigned c = xb_ld(&bar[XB_XCNT(j)]); sum += c; cnt += (c > 0u) ? 1u : 0u; mine = (j == x) ? c : mine; }
        if (sum == G) break;
        __builtin_amdgcn_s_sleep(1);
        if ((++sp & 255u) == 0u) { if (xb_ld(&bar[XB_TMO])) break; if (sp > XB_SPIN_CAP) { atomicAdd(&bar[XB_TMO], 1u); break; } }
    }
    nloc = mine > 0u ? mine : 1u; nx = cnt > 0u ? cnt : 1u;
}

__device__ __forceinline__ void xcd_barrier(const XcdBarrier& b, int tid  ) {
    asm volatile("s_waitcnt vmcnt(0)" ::: "memory");
    __syncthreads();
    if (tid == 0) {
        unsigned* bar = b.bar;
        __builtin_amdgcn_s_waitcnt(0);
        unsigned nloc = b.st[0], nx = b.st[1];
        if (nloc == 0u) { xcd_barrier_complete(bar, b.x, nloc, nx); b.st[0] = nloc; b.st[1] = nx; }
        const unsigned old = xb_add(&bar[XB_XSUB(b.x)], 1u);
        const unsigned gen = old / nloc;
        if (old + 1u == (gen + 1u) * nloc) {
            __builtin_amdgcn_fence(__ATOMIC_RELEASE, "agent");
            asm volatile("s_waitcnt vmcnt(0)" ::: "memory");
            const unsigned og = xb_add(&bar[XB_TOP], 1u);
            const unsigned tg = og / nx;
            if (og + 1u == (tg + 1u) * nx) xb_add(&bar[XB_TOPGEN], 1u);
            else XB_SPIN(xb_ld(&bar[XB_TOPGEN]) == tg, bar);
            __builtin_amdgcn_fence(__ATOMIC_ACQUIRE, "agent");
            xb_add(&bar[XB_XGEN(b.x)], 1u);
            asm volatile("s_waitcnt vmcnt(0)" ::: "memory");
        } else {
            XB_SPIN(xb_ld(&bar[XB_XGEN(b.x)]) == gen, bar);
            __builtin_amdgcn_fence(__ATOMIC_ACQUIRE, "agent");
            asm volatile("s_waitcnt vmcnt(0)" ::: "memory");
        }
    }
    __syncthreads();
}

struct Args { const float* in[25]; float* out; unsigned char* ws; int ph_lo, ph_hi; };
enum { I_X = 0, I_C, I_CTX, I_CCTX, I_WADA, I_BADA, I_NMG, I_NFG, I_WIN, I_LCW, I_LCB, I_LGW, I_LGB, I_LLAM, I_RPB, I_SLG, I_SLB, I_SW, I_SB, I_WOUT, I_FUP, I_FCW, I_FCB, I_FDN, I_FNG };
struct Frame {
    LAS unsigned char* lds;
    int tid, lane, wave, G, bid;
    unsigned char* ws; float* out;
    __device__ __forceinline__ const float* inp(int i) const { const unsigned long long v = *(const LAS unsigned long long*)(lds + PTR_OFF + 8 * i);
        return (const float*)(const GAS float*)(((unsigned long long)(unsigned)__builtin_amdgcn_readfirstlane((int)(v >> 32)) << 32) | (unsigned long long)(unsigned)__builtin_amdgcn_readfirstlane((int)(unsigned)v)); }
    __device__ __forceinline__ float* MOD() const { return (float*)(ws + WS_MOD); }
    __device__ __forceinline__ bf16* GWT() const { return (bf16*)(ws + WS_GWT); }
    __device__ __forceinline__ bf16* SWB() const { return (bf16*)(ws + WS_SWB); }
    __device__ __forceinline__ float* AGG() const { return (float*)(ws + WS_AGG); }
    __device__ __forceinline__ float* AGT() const { return (float*)(ws + WS_AGT); }
    __device__ __forceinline__ float* ROPE() const { return (float*)(ws + WS_ROPE); }
    __device__ __forceinline__ float* C8() const { return (float*)(ws + WS_ROPE + 16384); }
    __device__ __forceinline__ bf16* X() const { return (bf16*)(ws + WS_X); }
    __device__ __forceinline__ bf16* HX() const { return (bf16*)(ws + WS_HX); }
    __device__ __forceinline__ bf16* ACT() const { return (bf16*)(ws + WS_ACT); }
    __device__ __forceinline__ bf16* Z() const { return (bf16*)(ws + WS_Z); }
    __device__ __forceinline__ bf16* MIX() const { return (bf16*)(ws + WS_MIX); }
    __device__ __forceinline__ unsigned* AB2() const { return (unsigned*)(ws + WS_AB); }
    __device__ __forceinline__ bf16* U() const { return (bf16*)(ws + WS_U); }
    __device__ __forceinline__ bf16* QR() const { return (bf16*)(ws + WS_QR); }
    __device__ __forceinline__ bf16* KR() const { return (bf16*)(ws + WS_KR); }
    __device__ __forceinline__ bf16* VT() const { return (bf16*)(ws + WS_VT); }
    __device__ __forceinline__ bf16* KC() const { return (bf16*)(ws + WS_KC); }
    __device__ __forceinline__ bf16* VTC() const { return (bf16*)(ws + WS_VTC); }
};

__device__ __forceinline__ void p0_transpose_item(const float* W, int K, int N, bf16* WT, LAS float* scr, int item, int lane) {
    const int nblk = N / 32, kb = item / nblk, nb = item % nblk, k0 = 64 * kb, n0 = 32 * nb;
#pragma unroll 8
    for (int i = 0; i < 32; ++i) { const int kk = 2 * i + (lane >> 5); scr[kk * 33 + (lane & 31)] = W[(size_t)(k0 + kk) * N + n0 + (lane & 31)]; }
    LDS_WAIT(); asm volatile("" ::: "memory");
    const int c = lane & 7;
#pragma unroll
    for (int j = 0; j < 4; ++j) { const int n = (lane >> 3) + 8 * j; const LAS float* s = scr + (8 * c) * 33 + n;
        v4u o; o.x = pk2(s[0 * 33], s[1 * 33]); o.y = pk2(s[2 * 33], s[3 * 33]); o.z = pk2(s[4 * 33], s[5 * 33]); o.w = pk2(s[6 * 33], s[7 * 33]);
        *(v4u*)(WT + (size_t)(n0 + n) * K + k0 + 8 * c) = o; }
    LDS_WAIT(); asm volatile("" ::: "memory");
}
__device__ __forceinline__ void p0_adaln_unit(Frame& F, int L, int cb) {
    LAS float* sc = (LAS float*)F.lds;
    const float* c = F.inp(I_C); const float* cc = F.inp(I_CCTX);
    for (int i = F.tid; i < 9 * 2048; i += NTHREADS) { const int v = i >> 11, k = i & 2047; const float x = v < 8 ? c[v * 2048 + k] : cc[k]; sc[k * 12 + v] = silu_f(x); }
    __syncthreads();
    const float* W = F.inp(I_WADA) + (size_t)L * DM * MODW + cb * 256 + 4 * F.lane;
    f32x4 acc[9];
#pragma unroll
    for (int v = 0; v < 9; ++v) acc[v] = (f32x4){0.f, 0.f, 0.f, 0.f};
    const int kbeg = F.wave * 256;
    for (int k = kbeg; k < kbeg + 256; k += 8) {
        f32x4 w[8];
#pragma unroll
        for (int q = 0; q < 8; ++q) w[q] = *(const f32x4*)(W + (size_t)(k + q) * MODW);
#pragma unroll
        for (int q = 0; q < 8; ++q) {
            const f32x4 s0 = *(const LAS f32x4*)(sc + (k + q) * 12), s1 = *(const LAS f32x4*)(sc + (k + q) * 12 + 4); const float s8 = sc[(k + q) * 12 + 8];
            acc[0] += w[q] * s0.x; acc[1] += w[q] * s0.y; acc[2] += w[q] * s0.z; acc[3] += w[q] * s0.w;
            acc[4] += w[q] * s1.x; acc[5] += w[q] * s1.y; acc[6] += w[q] * s1.z; acc[7] += w[q] * s1.w; acc[8] += w[q] * s8;
        }
    }
    __syncthreads();
    LAS float* red = (LAS float*)F.lds;
#pragma unroll
    for (int v = 0; v < 9; ++v) *(LAS f32x4*)(red + (F.wave * 9 + v) * 256 + 4 * F.lane) = acc[v];
    __syncthreads();
    const float* bias = F.inp(I_BADA) + (size_t)L * MODW + cb * 256;
    for (int o = F.tid; o < 9 * 256; o += NTHREADS) { const int v = o >> 8, col = o & 255; float s = bias[col];
#pragma unroll
        for (int w = 0; w < 8; ++w) s += red[(w * 9 + v) * 256 + col];
        F.MOD()[((size_t)L * 9 + v) * MODW + cb * 256 + col] = s; }
    __syncthreads();
}
__device__ __forceinline__ void convert_layer(Frame& F, int L, int cu0, int ncu) {
    if (F.bid < cu0 || F.bid >= cu0 + ncu) return;
    LAS float* scr = (LAS float*)(F.lds + F.wave * 16384);
    const int gw = (F.bid - cu0) * NWAVES + F.wave, NGW = ncu * NWAVES;
    bf16* wt = (bf16*)(F.ws + WS_WT + (size_t)L * WT_LAYER);
    const float* w_in = F.inp(I_WIN) + (size_t)L * DM * PW; const float* w_out = F.inp(I_WOUT) + (size_t)L * DM * DM;
    const float* w_up = F.inp(I_FUP) + (size_t)L * DM * FU; const float* w_dn = F.inp(I_FDN) + (size_t)L * FH * DM;
    for (int it = gw; it < (DM / 64) * (PW / 32); it += NGW) p0_transpose_item(w_in, DM, PW, (bf16*)((char*)wt + WT_IN), scr, it, F.lane);
    for (int it = gw; it < (DM / 64) * (DM / 32); it += NGW) p0_transpose_item(w_out, DM, DM, (bf16*)((char*)wt + WT_OUT), scr, it, F.lane);
    for (int it = gw; it < (DM / 64) * (FU / 32); it += NGW) p0_transpose_item(w_up, DM, FU, (bf16*)((char*)wt + WT_UP), scr, it, F.lane);
    for (int it = gw; it < (FH / 64) * (DM / 32); it += NGW) p0_transpose_item(w_dn, FH, DM, (bf16*)((char*)wt + WT_DN), scr, it, F.lane);
}
__device__ __forceinline__ void p0_prologue(Frame& F) {
    for (int u = F.bid; u < DEPTH * 48; u += F.G) p0_adaln_unit(F, u / 48, u % 48);
    { const int gi = F.bid * NTHREADS + F.tid;
      if (gi < 1024) { const int pos = gi >> 4, f = gi & 15; double inv = 1.0; for (int i = 0; i < f; ++i) inv *= 0.5623413251903491;
          const float ang = (float)pos * (float)inv; double y = (double)ang; const double twopi = 6.283185307179586476925;
          const double kk = __builtin_rint(y / twopi); y -= kk * twopi; const double y2 = y * y;
          double cs = 1.0, sn = y, tc = 1.0, ts = y;
          for (int n = 1; n <= 16; ++n) { tc *= -y2 / (double)((2 * n - 1) * (2 * n)); ts *= -y2 / (double)((2 * n) * (2 * n + 1)); cs += tc; sn += ts; }
          F.ROPE()[gi * 2] = (float)cs; F.ROPE()[gi * 2 + 1] = (float)sn; } }
    { const int gi = F.bid * NTHREADS + F.tid, GN = F.G * NTHREADS; const float* gw = F.inp(I_LGW); const float* sw = F.inp(I_SW);
      for (int e = gi; e < DEPTH * 32 * 4096; e += GN) { const int m = e >> 12, o = (e >> 6) & 63, i = e & 63; F.GWT()[e] = (bf16)f2bf(gw[(size_t)m * 4096 + i * 64 + o]); }
      for (int e = gi; e < DEPTH * 8 * 16384; e += GN) F.SWB()[e] = (bf16)f2bf(sw[e]);
      const float* lam = F.inp(I_LLAM); for (int e = gi; e < DEPTH * 1024; e += GN) F.C8()[e] = -8.0f * log1pf(__expf(-lam[e])); }
    for (int L = 0; L < DEPTH; ++L) convert_layer(F, L, 0, F.G);
}

__device__ __forceinline__ void norm_rows(Frame& F, const float* src32, const bf16* src16, int row0, int nrows, const float* g, const float* sh, const float* sc) {
    f32x4 A[8], B[8];
#pragma unroll
    for (int j = 0; j < 8; ++j) { const int col = 4 * F.lane + 256 * j; const f32x4 gg = *(const f32x4*)(g + col), s = *(const f32x4*)(sc + col); A[j] = gg * (s + 1.0f); B[j] = *(const f32x4*)(sh + col); }
    for (int r = 0; r < nrows; ++r) {
        f32x4 v[8]; float s = 0.f;
        if (src32) { const f32x4* xr = (const f32x4*)(src32 + (size_t)(row0 + r) * DM) + F.lane;
#pragma unroll
            for (int j = 0; j < 8; ++j) v[j] = xr[64 * j]; }
        else { const v2u* xr = (const v2u*)(src16 + (size_t)(row0 + r) * DM) + F.lane;
#pragma unroll
            for (int j = 0; j < 8; ++j) { const v2u d = xr[64 * j]; v[j] = (f32x4){bflo(d.x), bfhi(d.x), bflo(d.y), bfhi(d.y)}; } }
#pragma unroll
        for (int j = 0; j < 8; ++j) s += (v[j].x * v[j].x + v[j].y * v[j].y) + (v[j].z * v[j].z + v[j].w * v[j].w);
        const float rstd = __builtin_amdgcn_rsqf(wave_sum(s, F.lane) * (1.0f / DM) + NORM_EPS);
        v2u* o = (v2u*)(F.HX() + (size_t)(row0 + r) * DM) + F.lane;
#pragma unroll
        for (int j = 0; j < 8; ++j) { const f32x4 y = v[j] * rstd * A[j] + B[j]; v2u w; w.x = pk2(y.x, y.y); w.y = pk2(y.z, y.w); o[64 * j] = w; }
    }
}
__device__ __forceinline__ void norm_range(Frame& F, int L, int which  , int r0, int r1) {
    if (r1 <= r0) return;
    const float* g = (which ? F.inp(I_NFG) : F.inp(I_NMG)) + (size_t)L * DM;
    const float* mod = F.MOD() + (size_t)L * 9 * MODW + (which ? 3 * DM : 0);
    const bool first = (L == 0 && which == 0);
    const int n = r1 - r0, per = (n + NWAVES - 1) / NWAVES; int a = r0 + F.wave * per, e = a + per < r1 ? a + per : r1;
    while (a < e) {
        const int v = a < MLAT ? (a >> 11) : 8; const int vend = a < MLAT ? ((a >> 11) + 1) << 11 : MALL; const int stop = e < vend ? e : vend;
        const float* m = mod + (size_t)v * MODW;
        const float* src32 = first ? (a < MLAT ? F.inp(I_X) : F.inp(I_CTX) - (size_t)MLAT * DM) : nullptr;
        norm_rows(F, src32, F.X(), a, stop - a, g, m, m + DM);
        a = stop;
    }
}
__device__ __forceinline__ void share(int rb, int re, int idx, int n, int& r0, int& r1) { const int per = (re - rb + n - 1) / n; r0 = rb + idx * per; r1 = r0 + per; if (r0 > re) r0 = re; if (r1 > re) r1 = re; }
__device__ __forceinline__ void final_norm_phase(Frame& F) {
    const int gw = F.bid * NWAVES + F.wave, NGW = F.G * NWAVES; const float* g = F.inp(I_FNG);
    f32x4 A[8];
#pragma unroll
    for (int j = 0; j < 8; ++j) A[j] = *(const f32x4*)(g + 4 * F.lane + 256 * j);
    for (int row = gw; row < MLAT; row += NGW) {
        const v2u* xr = (const v2u*)(F.X() + (size_t)row * DM) + F.lane; f32x4 v[8]; float s = 0.f;
#pragma unroll
        for (int j = 0; j < 8; ++j) { const v2u d = xr[64 * j]; v[j] = (f32x4){bflo(d.x), bfhi(d.x), bflo(d.y), bfhi(d.y)}; s += (v[j].x * v[j].x + v[j].y * v[j].y) + (v[j].z * v[j].z + v[j].w * v[j].w); }
        const float rstd = __builtin_amdgcn_rsqf(wave_sum(s, F.lane) * (1.0f / DM) + NORM_EPS);
        f32x4* o = (f32x4*)(F.out + (size_t)row * DM) + F.lane;
#pragma unroll
        for (int j = 0; j < 8; ++j) o[64 * j] = v[j] * rstd * A[j];
    }
}

__device__ __forceinline__ void convgate_phase(Frame& F, int L, int rbeg, int rend, int cu0, int ncu) {
    if (F.bid < cu0 || F.bid >= cu0 + ncu || rend <= rbeg) return;
    const int NRANGE = (ncu * NWAVES * 4) / 43;
    const int rlen = (rend - rbeg + NRANGE - 1) / NRANGE;
    const float* cw = F.inp(I_FCW) + (size_t)L * 3 * FU; const float* cbv = F.inp(I_FCB) + (size_t)L * FU;
    const bf16* U = F.U(); const v4u zero = (v4u){0u, 0u, 0u, 0u};
    for (int q = ((F.bid - cu0) * NWAVES + F.wave) * 4 + (F.lane >> 4); q < 43 * NRANGE; q += ncu * NWAVES * 4) {
        const int cb = q % 43, rg = q / 43, cl = F.lane & 15, j0 = cb * 128 + cl * 8;
        const int r_lo = rbeg + rg * rlen, r_hi = (r_lo + rlen < rend) ? r_lo + rlen : rend;
        float wa[3][8], wg[3][8], ba[8], bg[8];
#pragma unroll
        for (int k = 0; k < 3; ++k)
#pragma unroll
            for (int e = 0; e < 8; ++e) { wa[k][e] = cw[(size_t)k * FU + j0 + e]; wg[k][e] = cw[(size_t)k * FU + FH + j0 + e]; }
#pragma unroll
        for (int e = 0; e < 8; ++e) { ba[e] = cbv[j0 + e]; bg[e] = cbv[FH + j0 + e]; }
        v4u pA, pG, cA[4], cG[4], nA[4], nG[4];
#define CG_LD(r_, a_, g_) do { const int r__ = (r_); if (r__ >= rbeg && r__ < rend) { a_ = *(const v4u*)(U + (size_t)r__ * FU + j0); g_ = *(const v4u*)(U + (size_t)r__ * FU + FH + j0); } else { a_ = zero; g_ = zero; } } while (0)
        CG_LD(r_lo - 1, pA, pG);
#pragma unroll
        for (int i = 0; i < 4; ++i) CG_LD(r_lo + i, cA[i], cG[i]);
        for (int r = r_lo; r < r_hi; r += 4) {
#pragma unroll
            for (int i = 0; i < 4; ++i) CG_LD(r + 4 + i, nA[i], nG[i]);
#pragma unroll
            for (int i = 0; i < 4; ++i) {
                const int rr = r + i;
                if (rr < r_hi) {
                    const bool first = rr < MLAT ? (rr & 2047) == 0 : (rr & 255) == 0, last = rr < MLAT ? (rr & 2047) == 2047 : (rr & 255) == 255;
                    v4u la = (i == 0) ? pA : cA[(i + 3) & 3], lg = (i == 0) ? pG : cG[(i + 3) & 3], ra = (i == 3) ? nA[0] : cA[(i + 1) & 3], rgv = (i == 3) ? nG[0] : cG[(i + 1) & 3];
                    if (first) { la = zero; lg = zero; }
                    if (last) { ra = zero; rgv = zero; }
                    float xp[8], xc[8], xn[8], yp[8], yc[8], yn[8], o[8];
                    unpack8(la, xp); unpack8(cA[i], xc); unpack8(ra, xn); unpack8(lg, yp); unpack8(cG[i], yc); unpack8(rgv, yn);
#pragma unroll
                    for (int e = 0; e < 8; ++e) { const float a = ba[e] + wa[0][e] * xp[e] + wa[1][e] * xc[e] + wa[2][e] * xn[e]; const float g = bg[e] + wg[0][e] * yp[e] + wg[1][e] * yc[e] + wg[2][e] * yn[e]; o[e] = silu_f(g) * a; }
                    *(v4u*)(F.ACT() + (size_t)rr * FH + j0) = pack8(o);
                }
            }
            pA = cA[3]; pG = cG[3];
#pragma unroll
            for (int i = 0; i < 4; ++i) { cA[i] = nA[i]; cG[i] = nG[i]; }
        }
#undef CG_LD
    }
}

constexpr float AT_SC = 0.125f * 1.4426950408889634f;
__device__ __forceinline__ v4u rope_chunk(v4u own, int lane, bool is_x2, const float* cs  , float scale) {
    v4u par; par.x = shxu(own.x, 2, lane); par.y = shxu(own.y, 2, lane); par.z = shxu(own.z, 2, lane); par.w = shxu(own.w, 2, lane);
    float x[8], p[8], o[8]; unpack8(own, x); unpack8(par, p);
#pragma unroll
    for (int e = 0; e < 8; ++e) { const float c = cs[2 * e], s = cs[2 * e + 1]; o[e] = (is_x2 ? (x[e] * c + p[e] * s) : (x[e] * c - p[e] * s)) * scale; }
    return pack8(o);
}
__device__ __forceinline__ void prep_unit(Frame& F, bool ctx, int b, int h, int tt) {
    const int lane = F.lane, c = lane & 7;
    const int bh = b * NH + h;
    const size_t zrow0 = ctx ? (size_t)(MLAT + b * CTXL + 64 * tt) : (size_t)(b * SEQ + 64 * tt);
    const int half = c >> 2; const bool is_x2 = (c >> 1) & 1; const int f0 = 8 * (c & 1);
    struct PrepOps { v4u kq; f32x4 t4[4]; };
    PrepOps po[2];
#define PREP_LOAD(i_, o_) do { const int tl_ = 8 * (i_) + (lane >> 3); const bf16* zr_ = F.Z() + (zrow0 + tl_) * PW + 64 * h + 8 * c; \
        (o_).kq = ctx ? *(const v4u*)(F.KC() + ((size_t)bh * CTXL + 64 * tt + tl_) * 64 + 8 * c) : *(const v4u*)(F.KR() + ((size_t)bh * SEQ + 64 * tt + tl_) * 64 + 8 * c);     \
        if (!ctx) { const int pos_ = half ? tl_ : tt; \
            _Pragma("unroll") for (int e = 0; e < 4; ++e) (o_).t4[e] = *(const f32x4*)(F.ROPE() + (pos_ * 16 + f0) * 2 + 4 * e); } } while (0)
    PREP_LOAD(0, po[0]);
#pragma unroll
    for (int i = 0; i < 8; ++i) {
        if (i + 1 < 8) PREP_LOAD(i + 1, po[(i + 1) & 1]);
        __builtin_amdgcn_sched_barrier(0);
        const PrepOps& o = po[i & 1];
        const int tl = 8 * i + (lane >> 3);
        if (!ctx) {
            float cs[16];
#pragma unroll
            for (int e = 0; e < 4; ++e) { cs[4 * e] = o.t4[e].x; cs[4 * e + 1] = o.t4[e].y; cs[4 * e + 2] = o.t4[e].z; cs[4 * e + 3] = o.t4[e].w; }
            const size_t off = ((size_t)bh * SEQ + 64 * tt + tl) * 64 + 8 * c;
            *(v4u*)(F.KR() + off) = rope_chunk(o.kq, lane, is_x2, cs, AT_SC);
        } else {
            float kx[8]; unpack8(o.kq, kx);
#pragma unroll
            for (int e = 0; e < 8; ++e) kx[e] *= AT_SC;
            *(v4u*)(F.KC() + ((size_t)bh * CTXL + 64 * tt + tl) * 64 + 8 * c) = pack8(kx);
        }
        __builtin_amdgcn_sched_barrier(0);
    }
#undef PREP_LOAD
}

constexpr int XC_ROW = 68;
__device__ __forceinline__ float one_minus_exp_neg(float x) {
    const float p = x * (1.0f + x * (-0.5f + x * (0.16666667f + x * (-0.041666668f + x * (0.0083333338f + x * -0.0013888889f)))));
    return x < 0.125f ? p : 1.0f - __expf(-x);
}
__device__ __forceinline__ void lru_ab_unit(Frame& F, int L, int u) {
    const int mc = u >> 2, q4 = u & 3;
    const int lane = F.lane, tt = F.wave >> 1, g = 2 * q4 + (F.wave & 1), tok = lane & 15, kg = lane >> 4;
    const int R0 = 64 * mc, R = R0 + 16 * tt + tok;
    const int seq_lo = mc < 256 ? (mc >> 5) * SEQ : MLAT + ((mc - 256) >> 2) * CTXL, seq_hi = seq_lo + (mc < 256 ? SEQ : CTXL);
    LAS float* xcs = (LAS float*)(F.lds + F.wave * (16 * XC_ROW * 4));
    const float* gb = F.inp(I_LGB) + (size_t)L * 4 * 512; const float* c8t = F.C8() + (size_t)L * 2 * 512;
    struct GateOps { bf16x8 wr0, wr1, wi0, wi1; f32x4 gbr, gbi, c8; };
    GateOps ops[2];
#define LRU_LOAD_OPS(it_, o_) do { const int d_ = (it_) >> 2, ot_ = (it_) & 3; \
        const bf16* wp_ = F.GWT() + ((((size_t)L * 2 + d_) * 2) * 8 + g) * 4096 + (16 * ot_ + tok) * 64 + 8 * kg;     \
        (o_).wr0 = ldfrag(wp_); (o_).wr1 = ldfrag(wp_ + 32); (o_).wi0 = ldfrag(wp_ + 8 * 4096); (o_).wi1 = ldfrag(wp_ + 8 * 4096 + 32); \
        const int ch_ = 64 * g + 16 * ot_ + 4 * kg; \
        (o_).gbr = *(const f32x4*)(gb + (d_ * 2 + 0) * 512 + ch_); (o_).gbi = *(const f32x4*)(gb + (d_ * 2 + 1) * 512 + ch_); (o_).c8 = *(const f32x4*)(c8t + d_ * 512 + ch_); } while (0)
    {
        const float* cw = F.inp(I_LCW) + (size_t)L * 4 * 512 + 64 * g + 8 * kg; const float* cb = F.inp(I_LCB) + (size_t)L * 512 + 64 * g + 8 * kg;
        v4u z[2][4]; f32x4 w0[2][4], w1[2][4], b0[2], b1[2];
#pragma unroll
        for (int ks = 0; ks < 2; ++ks) {
#pragma unroll
            for (int k = 0; k < 4; ++k) { const int Rt = R + k - 2; z[ks][k] = (Rt >= seq_lo && Rt < seq_hi) ? *(const v4u*)(F.Z() + (size_t)Rt * PW + ZC_AX + 64 * g + 32 * ks + 8 * kg) : (v4u){0u, 0u, 0u, 0u};
                w0[ks][k] = *(const f32x4*)(cw + k * 512 + 32 * ks); w1[ks][k] = *(const f32x4*)(cw + k * 512 + 32 * ks + 4); }
            b0[ks] = *(const f32x4*)(cb + 32 * ks); b1[ks] = *(const f32x4*)(cb + 32 * ks + 4);
        }
        LRU_LOAD_OPS(0, ops[0]);
        __builtin_amdgcn_sched_barrier(0);
#pragma unroll
        for (int ks = 0; ks < 2; ++ks) {
            float a[8] = {b0[ks].x, b0[ks].y, b0[ks].z, b0[ks].w, b1[ks].x, b1[ks].y, b1[ks].z, b1[ks].w};
#pragma unroll
            for (int k = 0; k < 4; ++k) { float x[8]; unpack8(z[ks][k], x); const f32x4 u0 = w0[ks][k], u1 = w1[ks][k];
                a[0] += u0.x * x[0]; a[1] += u0.y * x[1]; a[2] += u0.z * x[2]; a[3] += u0.w * x[3]; a[4] += u1.x * x[4]; a[5] += u1.y * x[5]; a[6] += u1.z * x[6]; a[7] += u1.w * x[7]; }
            LAS f32x4* dst = (LAS f32x4*)(xcs + tok * XC_ROW + 32 * ks + 8 * kg);
            dst[0] = (f32x4){a[0], a[1], a[2], a[3]}; dst[1] = (f32x4){a[4], a[5], a[6], a[7]};
        }
    }
    LDS_WAIT(); asm volatile("" ::: "memory");
    bf16x8 xb[2];
    { const LAS float* xr = xcs + tok * XC_ROW;
#pragma unroll
      for (int ks = 0; ks < 2; ++ks) { const f32x4 x0 = *(const LAS f32x4*)(xr + 32 * ks + 8 * kg), x1 = *(const LAS f32x4*)(xr + 32 * ks + 8 * kg + 4);
          v4u pw; pw.x = pk2(x0.x, x0.y); pw.y = pk2(x0.z, x0.w); pw.z = pk2(x1.x, x1.y); pw.w = pk2(x1.z, x1.w); xb[ks] = __builtin_bit_cast(bf16x8, pw); } }
#pragma unroll
    for (int it = 0; it < 8; ++it) {
        if (it + 1 < 8) LRU_LOAD_OPS(it + 1, ops[(it + 1) & 1]);
        __builtin_amdgcn_sched_barrier(0);
        const GateOps& o = ops[it & 1]; const int d = it >> 2, ot = it & 3, ch = 64 * g + 16 * ot + 4 * kg;
        const f32x4 xd = *(const LAS f32x4*)(xcs + tok * XC_ROW + 16 * ot + 4 * kg);
        f32x4 ar = o.gbr, ai = o.gbi;
        ar = mfma16(o.wr0, xb[0], ar); ar = mfma16(o.wr1, xb[1], ar);
        ai = mfma16(o.wi0, xb[0], ai); ai = mfma16(o.wi1, xb[1], ai);
        v4u ov;
#pragma unroll
        for (int e = 0; e < 4; ++e) { const float r = sigm(ar[e]), ig = sigm(ai[e]);
            const float oma = 1.0f - __expf(o.c8[e] * r);
            const float bb = __builtin_amdgcn_sqrtf(oma * (2.0f - oma)) * (ig * xd[e]);
            ov[e] = pk2(oma, bb); }
        *(v4u*)(F.AB2() + (size_t)d * MALL * 512 + (size_t)R * 512 + ch) = ov;
        __builtin_amdgcn_sched_barrier(0);
    }
#undef LRU_LOAD_OPS
    __syncthreads();
    {
        const int cl = F.tid & 127, seg = F.tid >> 7, ch = 128 * q4 + cl;
        const unsigned* p0 = F.AB2() + (size_t)(R0 + 16 * seg) * 512 + ch; const unsigned* p1 = p0 + (size_t)MALL * 512;
        unsigned w0[16], w1[16];
#pragma unroll
        for (int t = 0; t < 16; ++t) { w0[t] = p0[t * 512]; w1[t] = p1[t * 512]; }
        float Af = 1.f, Bf = 0.f, Ab = 1.f, Bb = 0.f;
#pragma unroll
        for (int t = 0; t < 16; ++t) { const float a = 1.0f - bflo(w0[t]), b = bfhi(w0[t]); Bf = a * Bf + b; Af *= a; }
#pragma unroll
        for (int t = 15; t >= 0; --t) { const float a = 1.0f - bflo(w1[t]), b = bfhi(w1[t]); Bb = a * Bb + b; Ab *= a; }
        float* at = F.AGT() + ((size_t)(4 * mc + seg) * 2) * 512 + ch;
        at[0] = Af; at[512] = Bf; at[(size_t)4 * NCHUNK * 1024] = Ab; at[(size_t)4 * NCHUNK * 1024 + 512] = Bb;
        LAS f32x4* ex = (LAS f32x4*)(F.lds + 40960);
        ex[seg * 128 + cl] = (f32x4){Af, Bf, Ab, Bb};
        __syncthreads();
        if (seg == 0) {
            f32x4 e0 = ex[cl], e1 = ex[128 + cl], e2 = ex[256 + cl], e3 = ex[384 + cl];
            float A = e0.x, B = e0.y; B = e1.x * B + e1.y; A *= e1.x; B = e2.x * B + e2.y; A *= e2.x; B = e3.x * B + e3.y; A *= e3.x;
            float C = e3.z, D = e3.w; D = e2.z * D + e2.w; C *= e2.z; D = e1.z * D + e1.w; C *= e1.z; D = e0.z * D + e0.w; C *= e0.z;
            float* ag = F.AGG() + ((size_t)mc * 2) * 512 + ch;
            ag[0] = A; ag[512] = B; ag[(size_t)NCHUNK * 1024] = C; ag[(size_t)NCHUNK * 1024 + 512] = D;
        }
    }
    __syncthreads();
}
__device__ __forceinline__ void lru_d_unit(Frame& F, int u) {
    const int mc = u >> 2, q4 = u & 3;
    const int cl = F.tid & 127, seg = F.tid >> 7, ch = 128 * q4 + cl, R0 = 64 * mc + 16 * seg;
    const unsigned* p0 = F.AB2() + (size_t)R0 * 512 + ch; const unsigned* p1 = p0 + (size_t)MALL * 512;
    const bf16* yp = F.Z() + (size_t)R0 * PW + ZC_AY + ch; bf16* op = F.MIX() + (size_t)R0 * DM + ch;
    unsigned w0[16], w1[16]; bf16 yv[16];
#pragma unroll
    for (int t = 0; t < 16; ++t) { w0[t] = p0[t * 512]; w1[t] = p1[t * 512]; yv[t] = yp[(size_t)t * PW]; }
    float taf[4][2], tab[4][2];
    { const float* atf = F.AGT() + ch; const float* atb = F.AGT() + (size_t)4 * NCHUNK * 1024 + ch;
#pragma unroll
      for (int sgi = 0; sgi < 4; ++sgi) { const float* a = atf + (size_t)(4 * mc + sgi) * 1024; const float* c = atb + (size_t)(4 * mc + sgi) * 1024; taf[sgi][0] = a[0]; taf[sgi][1] = a[512]; tab[sgi][0] = c[0]; tab[sgi][1] = c[512]; } }
    __builtin_amdgcn_sched_barrier(0);
    const float* agf = F.AGG() + ch; const float* agb = F.AGG() + (size_t)NCHUNK * 1024 + ch;
    float hf = 0.f, hb = 0.f;
    const bool lat = mc < 256; const int b = lat ? (mc >> 5) : ((mc - 256) >> 2), lc = lat ? (mc & 31) : ((mc - 256) & 3);
    const int cbase = 256 + 4 * b, lbase = 32 * b;
    const int nfc = lat ? 4 : lc, nfl = lat ? lc : 0, nbc = lat ? 4 : 3 - lc, nbl = lat ? 31 - lc : 0;
#pragma unroll 4
    for (int p = 0; p < 4; ++p) {
        if (p < nfc) { const float* a = agf + (size_t)(cbase + p) * 1024; hf = a[0] * hf + a[512]; }
        if (p < nbc) { const float* a = agb + (size_t)(cbase + 3 - p) * 1024; hb = a[0] * hb + a[512]; }
    }
    { const int nmax = nfl > nbl ? nfl : nbl;
#pragma unroll 8
      for (int p = 0; p < nmax; ++p) {
          const int pf = p < nfl ? p : 0, pb = p < nbl ? p : 0;
          const float* a = agf + (size_t)(lbase + pf) * 1024; const float* c = agb + (size_t)(lbase + 31 - pb) * 1024;
          const float a0 = a[0], a1 = a[512], c0 = c[0], c1 = c[512];
          hf = p < nfl ? a0 * hf + a1 : hf; hb = p < nbl ? c0 * hb + c1 : hb; } }
#pragma unroll
    for (int sgi = 0; sgi < 3; ++sgi) hf = sgi < seg ? taf[sgi][0] * hf + taf[sgi][1] : hf;
#pragma unroll
    for (int sgi = 3; sgi > 0; --sgi) hb = sgi > seg ? tab[sgi][0] * hb + tab[sgi][1] : hb;
    float hfv[16];
#pragma unroll
    for (int t = 0; t < 16; ++t) { hf = (1.0f - bflo(w0[t])) * hf + bfhi(w0[t]); hfv[t] = hf; }
#pragma unroll
    for (int t = 15; t >= 0; --t) { hb = (1.0f - bflo(w1[t])) * hb + bfhi(w1[t]); op[(size_t)t * DM] = (bf16)f2bf((hfv[t] + hb) * gelu_t(bf1(yv[t]))); }
}

constexpr int AT_CTX_OFF = 61440, AT_RPB_OFF = AT_CTX_OFF + 65536;
constexpr int AT_ROPE_OFF = AT_RPB_OFF + 2560;
static_assert(AT_ROPE_OFF % 16 == 0 && AT_ROPE_OFF + 8192 <= PTR_OFF, "attention LDS map");
constexpr int AT_BX_OFF = AT_CTX_OFF + 32768;
struct AtUnit { int bh, r0, c0, qrow0; };
template <bool WIN> __device__ __forceinline__ void at_geom(const AtUnit& u, int& rs0, int& nlr, int& kc0) {
    rs0 = u.r0 - 4 < 0 ? 0 : (u.r0 - 4 > 24 ? 24 : u.r0 - 4); const int rl = u.r0 + 7 - 4 > 24 ? 24 : u.r0 + 7 - 4; nlr = WIN ? rl + 8 - rs0 : 0;
    kc0 = u.c0 - 8 < 0 ? 0 : (u.c0 - 8 > 32 ? 32 : u.c0 - 8);
}
template <bool WIN, int PART = 0  > __device__ __forceinline__ void at_load_k(Frame& F, int tid, const AtUnit& u, v4u (&reg)[12], float& rpbv, int L) {
    int rs0, nlr, kc0; at_geom<WIN>(u, rs0, nlr, kc0);
    if constexpr (WIN && PART != 2) rpbv = F.inp(I_RPB)[((size_t)L * NH + (u.bh & 15)) * 465 + (tid < 465 ? tid : 464)];
    if constexpr (WIN && PART != 2) {
#pragma unroll
        for (int jj = 0; jj < 8; ++jj) { const int n = tid + 512 * jj; const int i = n & 15, c = (n >> 4) & 7, tile = n >> 7, T = tile & 1; int lr = tile >> 1; lr = lr < nlr ? lr : nlr - 1;
            reg[jj] = *(const v4u*)(F.KR() + ((size_t)u.bh * SEQ + (rs0 + lr) * 64 + kc0 + 8 * (i >> 2) + 4 * T + (i & 3)) * 64 + 8 * c); }
    }
    if constexpr (PART != 1)
#pragma unroll
    for (int jj = 0; jj < 4; ++jj) { const int n = tid + 512 * jj, i = n & 15, c = (n >> 4) & 7, tile = n >> 7;
        reg[8 + jj] = *(const v4u*)(F.KC() + ((size_t)u.bh * CTXL + 32 * (tile >> 1) + 8 * (i >> 2) + 4 * (tile & 1) + (i & 3)) * 64 + 8 * c); }
}
template <bool WIN> __device__ __forceinline__ void at_load_v(Frame& F, int tid, const AtUnit& u, v4u (&reg)[12]) {
    int rs0, nlr, kc0; at_geom<WIN>(u, rs0, nlr, kc0);
    const int h = u.bh & 15, b = u.bh >> 4, c = tid & 7, col = (tid >> 3) & 31, lr0 = tid >> 8;
    if constexpr (WIN) {
        const bf16* base = F.VT() + ((size_t)u.bh * SEQ + rs0 * 64 + kc0) * 64;
        const unsigned lane_off = (unsigned)(col * 64 + 8 * c);
#pragma unroll
        for (int jj = 0; jj < 8; ++jj) { int lr = lr0 + 2 * jj; lr = lr < nlr ? lr : nlr - 1;
            reg[jj] = *(const v4u*)(base + (lane_off + (unsigned)lr * 4096u)); }
    }
    { const bf16* base = F.VTC() + (size_t)u.bh * CTXL * 64;
#pragma unroll
      for (int jj = 0; jj < 4; ++jj) reg[8 + jj] = *(const v4u*)(base + (unsigned)(tid + 512 * jj) * 8u); }
}
__device__ __forceinline__ int at_vswz(int tid) { const int r = (tid >> 3) & 31; return (((r >> 1) & 1) | (((r >> 3) & 1) << 1)) << 5; }
template <bool WIN, bool VIMG = false> __device__ __forceinline__ void at_store(Frame& F, int tid, const AtUnit& u, const v4u (&reg)[12]) {
    int rs0, nlr, kc0; at_geom<WIN>(u, rs0, nlr, kc0);
    const int x = VIMG ? at_vswz(tid) : 0;
    if constexpr (WIN) {
#pragma unroll
        for (int jj = 0; jj < 8; ++jj) { const int n = tid + 512 * jj; if (n < nlr * 256) *(LAS v4u*)(F.lds + ((n * 16) ^ x)) = reg[jj]; }
    }
#pragma unroll
    for (int jj = 0; jj < 4; ++jj) { const int n = tid + 512 * jj; *(LAS v4u*)(F.lds + AT_CTX_OFF + ((n * 16) ^ x)) = reg[8 + jj]; }
}
#define AT_LDS_FRAG(off) (*(const LAS bf16x8*)(F.lds + (off)))
struct AtStat { float m1, l1, m2, l2; };
__device__ __forceinline__ float vmax3(float a, float b, float c) { float r; asm("v_max3_f32 %0, %1, %2, %3" : "=v"(r) : "v"(a), "v"(b), "v"(c)); return r; }
template <int NTILE> __device__ __forceinline__ void at_softmax_part(const f32x4 (&S)[NTILE], v4u* pw, float& m_out, float& l_out, int lane) {
    float ma = vmax3(S[0][0], S[0][1], S[0][2]), mb = vmax3(S[1][0], S[1][1], S[1][2]);
    ma = vmax3(ma, S[0][3], S[1][3]);
#pragma unroll
    for (int t = 2; t < NTILE; t += 2) { ma = vmax3(ma, S[t][0], S[t][1]); mb = vmax3(mb, S[t][2], S[t][3]); ma = vmax3(ma, S[t + 1][0], S[t + 1][1]); mb = vmax3(mb, S[t + 1][2], S[t + 1][3]); }
    float m = fmaxf(ma, mb);
    m = fmaxf(m, shx(m, 16, lane)); m = fmaxf(m, shx(m, 32, lane));
    const f32x2_t m2 = {m, m}; f32x2_t sum2 = {0.f, 0.f};
#pragma unroll
    for (int ks = 0; ks < NTILE / 2; ++ks) {
        unsigned w[4];
#pragma unroll
        for (int hh = 0; hh < 4; ++hh) {
            const f32x4 s4 = S[2 * ks + (hh >> 1)];
            const f32x2_t d = (f32x2_t){s4[2 * (hh & 1)], s4[2 * (hh & 1) + 1]} - m2;
            const f32x2_t pr = {__builtin_amdgcn_exp2f(d.x), __builtin_amdgcn_exp2f(d.y)};
            sum2 += pr; w[hh] = pk2(pr.x, pr.y);
        }
        pw[ks] = (v4u){w[0], w[1], w[2], w[3]};
    }
    float sum = sum2.x + sum2.y;
    sum += shx(sum, 16, lane); sum += shx(sum, 32, lane);
    m_out = m; l_out = sum;
}
__device__ __forceinline__ void at_build_bias(Frame& F, int tid, int c0, int kc0) {
    const LAS float* rpb = (const LAS float*)(F.lds + AT_RPB_OFF);
#pragma unroll
    for (int jj = 0; jj < 4; ++jj) { const int n = tid + 512 * jj;
        if (n < 15 * 128) { const int row = n >> 7, T = (n >> 6) & 1, kg = (n >> 4) & 3, q = n & 15;
            const int qcol = c0 + q, cs = qcol - 8 < 0 ? 0 : (qcol - 8 > 48 ? 48 : qcol - 8), kcol0 = kc0 + 8 * kg + 4 * T;
            f32x4 v;
#pragma unroll
            for (int e = 0; e < 4; ++e) { const int kcol = kcol0 + e; int rc = kcol - qcol + 15; rc = rc < 0 ? 0 : (rc > 30 ? 30 : rc);
                float bv = rpb[row * 31 + rc]; asm volatile("" : "+v"(bv));
                v[e] = (kcol >= cs && kcol < cs + 16) ? bv : -1e30f; }
            *(LAS f32x4*)(F.lds + AT_BX_OFF + n * 16) = v; } }
}
struct AtQ { bf16x8 w0, w1; };
template <bool WIN> __device__ __forceinline__ void at_load_q(Frame& F, int tid, const AtUnit& u, AtQ& Q) {
    const int lane = tid & 63, q = lane & 15, kg = lane >> 4;
    const int r = u.r0 + F.wave, h = u.bh & 15, b = u.bh >> 4;
    const size_t qrow = WIN ? (size_t)(b * SEQ + r * 64 + u.c0 + q) : (size_t)(u.qrow0 + 16 * F.wave + q);
    const bf16* qraw = WIN ? F.QR() + ((size_t)u.bh * SEQ + r * 64 + u.c0 + q) * 64 + 8 * kg : F.Z() + qrow * PW + ZC_Q + 64 * h + 8 * kg;
    Q.w0 = ldfrag(qraw); Q.w1 = ldfrag(qraw + 32);
}
template <bool WIN> __device__ __forceinline__ void at_scores(Frame& F, int tid, const AtUnit& u, int L, const AtQ& Q, v4u* pw, AtStat& st, v4u (&rv)[12]) {
    const int lane = tid & 63, q = lane & 15, kg = lane >> 4;
    const f32x4 z4 = (f32x4){0.f, 0.f, 0.f, 0.f};
    int rs0, nlr, kc0; at_geom<WIN>(u, rs0, nlr, kc0);
    const int r = u.r0 + F.wave, rs = r - 4 < 0 ? 0 : (r - 4 > 24 ? 24 : r - 4), lr0 = rs - rs0;
    const int foff = (kg * 16 + q) * 16;
    st.m1 = -3e38f; st.l1 = 0.f;
    if constexpr (WIN) {
        const int boff = AT_BX_OFF + (rs - r + 7) * 2048 + foff;
        bf16x8 qr0, qr1;
        { const bool is_x2 = (kg >> 1) & 1; const int f0 = 8 * (kg & 1), qcol = u.c0 + q;
          const LAS f32x4* tr = (const LAS f32x4*)(F.lds + AT_ROPE_OFF + (r * 32 + 2 * f0) * 4); const LAS f32x4* tc = (const LAS f32x4*)(F.lds + AT_ROPE_OFF + (qcol * 32 + 2 * f0) * 4);
          f32x4 cr[4], cc[4];
#pragma unroll
          for (int e = 0; e < 4; ++e) { cr[e] = tr[e]; cc[e] = tc[e]; }
          const v4u a0 = __builtin_bit_cast(v4u, Q.w0), a1 = __builtin_bit_cast(v4u, Q.w1);
          v4u p0, p1; p0.x = shxu(a0.x, 32, lane); p0.y = shxu(a0.y, 32, lane); p0.z = shxu(a0.z, 32, lane); p0.w = shxu(a0.w, 32, lane);
          p1.x = shxu(a1.x, 32, lane); p1.y = shxu(a1.y, 32, lane); p1.z = shxu(a1.z, 32, lane); p1.w = shxu(a1.w, 32, lane);
          float x[8], pp[8], o[8];
          unpack8(a0, x); unpack8(p0, pp);
#pragma unroll
          for (int e = 0; e < 8; ++e) { const float c = cr[e >> 1][2 * (e & 1)], s = cr[e >> 1][2 * (e & 1) + 1]; o[e] = is_x2 ? (x[e] * c + pp[e] * s) : (x[e] * c - pp[e] * s); }
          qr0 = __builtin_bit_cast(bf16x8, pack8(o));
          unpack8(a1, x); unpack8(p1, pp);
#pragma unroll
          for (int e = 0; e < 8; ++e) { const float c = cc[e >> 1][2 * (e & 1)], s = cc[e >> 1][2 * (e & 1) + 1]; o[e] = is_x2 ? (x[e] * c + pp[e] * s) : (x[e] * c - pp[e] * s); }
          qr1 = __builtin_bit_cast(bf16x8, pack8(o)); }
        const int koff = lr0 * 4096 + foff;
        struct WT { bf16x8 k0, k1; f32x4 c; };
        WT wb[2][2];
#define AT_WLOAD(ir_, b_) do { _Pragma("unroll") for (int T = 0; T < 2; ++T) { const int to_ = koff + (ir_) * 4096 + T * 2048; (b_)[T].k0 = AT_LDS_FRAG(to_); (b_)[T].k1 = AT_LDS_FRAG(to_ + 1024); \
            (b_)[T].c = *(const LAS f32x4*)(F.lds + boff + (ir_) * 2048 + T * 1024); } } while (0)
        f32x4 S[16];
        AT_WLOAD(0, wb[0]);
#pragma unroll
        for (int ir = 0; ir < 8; ++ir) {
            if (ir + 1 < 8) AT_WLOAD(ir + 1, wb[(ir + 1) & 1]);
            __builtin_amdgcn_sched_barrier(0);
            const WT (&w)[2] = wb[ir & 1];
            const f32x4 a0 = mfma16(w[0].k0, qr0, w[0].c), a1 = mfma16(w[1].k0, qr0, w[1].c);
            S[2 * ir] = mfma16(w[0].k1, qr1, a0); S[2 * ir + 1] = mfma16(w[1].k1, qr1, a1);
            __builtin_amdgcn_sched_barrier(0);
        }
#undef AT_WLOAD
        at_softmax_part<16>(S, pw, st.m1, st.l1, lane);
    }
    {
        struct CT { bf16x8 k0, k1; };
        CT cb[2][2];
#define AT_CLOAD(s_, b_) do { _Pragma("unroll") for (int T = 0; T < 2; ++T) { const int to_ = AT_CTX_OFF + (2 * (s_) + T) * 2048 + foff; (b_)[T].k0 = AT_LDS_FRAG(to_); (b_)[T].k1 = AT_LDS_FRAG(to_ + 1024); } } while (0)
        f32x4 S[16];
        AT_CLOAD(0, cb[0]);
#pragma unroll
        for (int s = 0; s < 8; ++s) {
            if (s + 1 < 8) AT_CLOAD(s + 1, cb[(s + 1) & 1]);
            __builtin_amdgcn_sched_barrier(0);
            const CT (&w)[2] = cb[s & 1];
            const f32x4 a0 = mfma16(w[0].k0, Q.w0, z4), a1 = mfma16(w[1].k0, Q.w0, z4);
            S[2 * s] = mfma16(w[0].k1, Q.w1, a0); S[2 * s + 1] = mfma16(w[1].k1, Q.w1, a1);
            __builtin_amdgcn_sched_barrier(0);
        }
#undef AT_CLOAD
        at_softmax_part<16>(S, pw + (WIN ? 8 : 0), st.m2, st.l2, lane);
    }
}
template <bool WIN> __device__ __forceinline__ void at_pv(Frame& F, int tid, const AtUnit& u, const v4u* pw, const AtStat& st) {
    const int lane = tid & 63, q = lane & 15, kg = lane >> 4;
    const f32x4 z4 = (f32x4){0.f, 0.f, 0.f, 0.f};
    int rs0, nlr, kc0; at_geom<WIN>(u, rs0, nlr, kc0);
    const int r = u.r0 + F.wave, rs = r - 4 < 0 ? 0 : (r - 4 > 24 ? 24 : r - 4), lr0 = rs - rs0;
    const int h = u.bh & 15, b = u.bh >> 4;
    typedef short s4v __attribute__((ext_vector_type(4)));
    const int qq = (lane >> 2) & 3, pp = lane & 3, sgm = ((qq >> 1) & 1) | ((kg & 1) << 1);
    const int rowoff = (8 * kg + qq) * 128 + 8 * pp;
    constexpr int NKS = WIN ? 16 : 8;
    const int wbase = lr0 * 4096 + rowoff, cbase = AT_CTX_OFF + rowoff;
    f32x4 O[4] = {z4, z4, z4, z4}, Ow[4] = {z4, z4, z4, z4};
    bf16x8 vf[3][4];
#define AT_VLOAD(ks_, b_) do { const int vo_ = (WIN && (ks_) < 8) ? wbase + (ks_) * 4096 : cbase + ((ks_) - (WIN ? 8 : 0)) * 4096; \
        _Pragma("unroll") for (int dt = 0; dt < 4; ++dt) { const int a_ = vo_ + ((dt ^ sgm) << 5); \
            const s4v lo_ = __builtin_amdgcn_ds_read_tr16_b64_v4i16((LAS s4v*)(F.lds + a_)), hi_ = __builtin_amdgcn_ds_read_tr16_b64_v4i16((LAS s4v*)(F.lds + a_ + 512)); \
            (b_)[dt] = __builtin_shufflevector(lo_, hi_, 0, 1, 2, 3, 4, 5, 6, 7); } } while (0)
    AT_VLOAD(0, vf[0]); AT_VLOAD(1, vf[1]);
#pragma unroll
    for (int ks = 0; ks < NKS; ++ks) {
        if (ks + 2 < NKS) AT_VLOAD(ks + 2, vf[(ks + 2) % 3]);
        __builtin_amdgcn_sched_barrier(0);
        const bf16x8 pf = __builtin_bit_cast(bf16x8, pw[ks]);
        if (WIN && ks < 8) {
#pragma unroll
            for (int dt = 0; dt < 4; ++dt) Ow[dt] = mfma16(vf[ks % 3][dt], pf, Ow[dt]);
        } else {
#pragma unroll
            for (int dt = 0; dt < 4; ++dt) O[dt] = mfma16(vf[ks % 3][dt], pf, O[dt]);
        }
        __builtin_amdgcn_sched_barrier(0);
    }
#undef AT_VLOAD
    float lsum = st.l2;
    if constexpr (WIN) {
        const float m = fmaxf(st.m1, st.m2), f1 = __builtin_amdgcn_exp2f(st.m1 - m), f2 = __builtin_amdgcn_exp2f(st.m2 - m);
#pragma unroll
        for (int dt = 0; dt < 4; ++dt) O[dt] = O[dt] * f2 + Ow[dt] * f1;
        lsum = st.l2 * f2 + st.l1 * f1;
    }
    const float inv = __builtin_amdgcn_rcpf(lsum);
    const size_t orow = WIN ? (size_t)(b * SEQ + r * 64 + u.c0 + q) : (size_t)(u.qrow0 + 16 * F.wave + q);
    bf16* out = F.MIX() + orow * DM + 512 + 64 * h + 4 * kg;
#pragma unroll
    for (int dt = 0; dt < 4; ++dt) { v2u w; w.x = pk2(O[dt][0] * inv, O[dt][1] * inv); w.y = pk2(O[dt][2] * inv, O[dt][3] * inv); *(v2u*)(out + 16 * dt) = w; }
}
#undef AT_LDS_FRAG
#define AT_BAR() asm volatile("s_waitcnt lgkmcnt(0)\n\ts_barrier" ::: "memory")
template <bool WIN, bool QUEUE, class UnitFn> __device__ __forceinline__ void attn_units(Frame& F, int L, int nunits, UnitFn unit_of, unsigned* qctr) {
    if (nunits <= 0) return;
    v4u rk[12], rv[12]; float rpbv = 0.f;
    volatile LAS int* qslot = (volatile LAS int*)(F.lds + AT_RPB_OFF + 2048);
    int cur = 0, nxt = 1;
    if constexpr (QUEUE) {
        if (F.tid == 0) { qslot[0] = (int)__hip_atomic_fetch_add(qctr, 1u, __ATOMIC_RELAXED, __HIP_MEMORY_SCOPE_AGENT); qslot[1] = (int)__hip_atomic_fetch_add(qctr, 1u, __ATOMIC_RELAXED, __HIP_MEMORY_SCOPE_AGENT); }
        __syncthreads();
        cur = __builtin_amdgcn_readfirstlane(qslot[0]); nxt = __builtin_amdgcn_readfirstlane(qslot[1]);
        __syncthreads();
        if (cur >= nunits) return;
    }
    if constexpr (WIN) *(LAS f32x4*)(F.lds + AT_ROPE_OFF + F.tid * 16) = *(const f32x4*)(F.ROPE() + F.tid * 4);
    AtUnit u = unit_of(cur);
#define AT_OPQ(x) ({ int o_ = (x); asm volatile("" : "+v"(o_)); o_; })
    at_load_k<WIN>(F, AT_OPQ(F.tid), u, rk, rpbv, L);
    AtQ Q; at_load_q<WIN>(F, AT_OPQ(F.tid), u, Q);
#pragma unroll 1
    for (;;) {
        const int tid = AT_OPQ(F.tid);
        int nn = nxt + 1;
        int fetched = 0;
        if constexpr (QUEUE) { if (tid == 0) { int zo_ = 0; asm volatile("" : "+v"(zo_));
                fetched = (int)__hip_atomic_fetch_add(qctr + zo_, 1u, __ATOMIC_RELAXED, __HIP_MEMORY_SCOPE_AGENT); } }
        AT_BAR();
        at_store<WIN>(F, AT_OPQ(tid), u, rk);
        if (WIN && tid < 465) *(LAS float*)(F.lds + AT_RPB_OFF + 4 * tid) = rpbv * 1.4426950408889634f;
        at_load_v<WIN>(F, AT_OPQ(tid), u, rv);
        if constexpr (WIN) { const AtUnit un0 = unit_of(nxt < nunits ? nxt : cur); at_load_k<WIN, 2>(F, AT_OPQ(tid), un0, rk, rpbv, L); }
        __builtin_amdgcn_sched_barrier(0);
        AT_BAR();
        if constexpr (WIN) { int rs0_, nlr_, kc0_; at_geom<WIN>(u, rs0_, nlr_, kc0_); at_build_bias(F, AT_OPQ(tid), u.c0, kc0_); AT_BAR(); }
        v4u pw[WIN ? 16 : 8]; AtStat st;
        at_scores<WIN>(F, AT_OPQ(tid), u, L, Q, pw, st, rv);
        if constexpr (QUEUE) { if (tid == 0) qslot[0] = fetched; }
        AT_BAR();
        if constexpr (QUEUE) nn = __builtin_amdgcn_readfirstlane(qslot[0]);
        const bool more = nxt < nunits;
        const AtUnit un = unit_of(more ? nxt : cur);
        at_store<WIN, true>(F, AT_OPQ(tid), u, rv);
        if constexpr (WIN) at_load_k<WIN, 1>(F, AT_OPQ(tid), un, rk, rpbv, L); else at_load_k<WIN>(F, AT_OPQ(tid), un, rk, rpbv, L);
        at_load_q<WIN>(F, AT_OPQ(tid), un, Q);
        AT_BAR();
        at_pv<WIN>(F, AT_OPQ(tid), u, pw, st);
        if (!more) break;
        u = un; cur = nxt; nxt = nn;
    }
    __syncthreads();
}
#undef AT_OPQ
#undef AT_BAR

constexpr int SG_ROW = 132;
__device__ __forceinline__ void sgu_unit(Frame& F, int L, int ck) {
    const int lane = F.lane, w = F.wave; const size_t row0 = (size_t)128 * ck;
    LAS bf16* vnT = (LAS bf16*)F.lds;
    const float* lg = F.inp(I_SLG) + (size_t)L * 512 + 8 * lane; const float* lb = F.inp(I_SLB) + (size_t)L * 512 + 8 * lane;
    float g8[8], b8[8];
#pragma unroll
    for (int e = 0; e < 8; ++e) { g8[e] = lg[e]; b8[e] = lb[e]; }
    for (int t4 = 0; t4 < 4; ++t4) {
        float x[4][8], s[4], q[4];
#pragma unroll
        for (int i = 0; i < 4; ++i) unpack8(*(const v4u*)(F.Z() + (row0 + 16 * w + 4 * t4 + i) * PW + ZC_SV + 8 * lane), x[i]);
#pragma unroll
        for (int i = 0; i < 4; ++i) { s[i] = 0.f;
#pragma unroll
            for (int e = 0; e < 8; ++e) { x[i][e] = gelu_t(x[i][e]); s[i] += x[i][e]; } }
#pragma unroll
        for (int o = 1; o < 64; o <<= 1)
#pragma unroll
            for (int i = 0; i < 4; ++i) s[i] += shx(s[i], o, lane);
#pragma unroll
        for (int i = 0; i < 4; ++i) { const float mean = s[i] * (1.0f / 512.0f); q[i] = 0.f;
#pragma unroll
            for (int e = 0; e < 8; ++e) { x[i][e] -= mean; q[i] += x[i][e] * x[i][e]; } }
#pragma unroll
        for (int o = 1; o < 64; o <<= 1)
#pragma unroll
            for (int i = 0; i < 4; ++i) q[i] += shx(q[i], o, lane);
#pragma unroll
        for (int i = 0; i < 4; ++i) { const int tok = 16 * w + 4 * t4 + i; const float rstd = __builtin_amdgcn_rsqf(q[i] * (1.0f / 512.0f) + NORM_EPS);
#pragma unroll
            for (int e = 0; e < 8; ++e) { const int e2 = (e + lane) & 7;
                float val = 0.f;
#pragma unroll
                for (int k = 0; k < 8; ++k) if (k == e2) val = x[i][k] * rstd * g8[k] + b8[k];
                vnT[(8 * lane + e2) * SG_ROW + tok] = (bf16)f2bf(val); } }
    }
    __syncthreads();
    {
        const int g = w, dl = lane & 15, kg = lane >> 4;
        typedef unsigned long long u64;
        bf16x8 A[4][4];
#pragma unroll
        for (int dt = 0; dt < 4; ++dt)
#pragma unroll
            for (int ks = 0; ks < 4; ++ks) { const LAS u64* p = (const LAS u64*)(vnT + (64 * g + 16 * dt + dl) * SG_ROW + 32 * ks + 8 * kg);
                const u64 lo = p[0], hi = p[1]; v4u wv; wv.x = (unsigned)lo; wv.y = (unsigned)(lo >> 32); wv.z = (unsigned)hi; wv.w = (unsigned)(hi >> 32); A[dt][ks] = __builtin_bit_cast(bf16x8, wv); }
        const bf16* Wg = F.SWB() + ((size_t)L * 8 + g) * 16384; const float* sb = F.inp(I_SB) + ((size_t)L * 8 + g) * 128;
        struct SgOps { bf16x8 Bf[4]; float bias; v2u uw[4]; };
        SgOps so[2];
#define SG_LOAD(pt_, o_) do { const int p_ = 16 * (pt_) + dl; \
            _Pragma("unroll") for (int ks = 0; ks < 4; ++ks) (o_).Bf[ks] = ldfrag(Wg + p_ * 128 + 32 * ks + 8 * kg); \
            (o_).bias = sb[p_]; \
            _Pragma("unroll") for (int dt = 0; dt < 4; ++dt) (o_).uw[dt] = *(const v2u*)(F.Z() + (row0 + p_) * PW + ZC_SU + 64 * g + 16 * dt + 4 * kg); } while (0)
        SG_LOAD(0, so[0]);
#pragma unroll
        for (int pt = 0; pt < 8; ++pt) {
            if (pt + 1 < 8) SG_LOAD(pt + 1, so[(pt + 1) & 1]);
            __builtin_amdgcn_sched_barrier(0);
            const SgOps& o = so[pt & 1]; const int p = 16 * pt + dl;
#pragma unroll
            for (int dt = 0; dt < 4; ++dt) {
                f32x4 acc = (f32x4){0.f, 0.f, 0.f, 0.f};
#pragma unroll
                for (int ks = 0; ks < 4; ++ks) acc = mfma16(A[dt][ks], o.Bf[ks], acc);
                const int d = 64 * g + 16 * dt + 4 * kg; const v2u uw = o.uw[dt];
                const float o0 = gelu_t(bflo(uw.x)) * (acc[0] + o.bias), o1 = gelu_t(bfhi(uw.x)) * (acc[1] + o.bias), o2 = gelu_t(bflo(uw.y)) * (acc[2] + o.bias), o3 = gelu_t(bfhi(uw.y)) * (acc[3] + o.bias);
                v2u ow; ow.x = pk2(o0, o1); ow.y = pk2(o2, o3);
                *(v2u*)(F.MIX() + (row0 + p) * DM + 1536 + d) = ow;
            }
            __builtin_amdgcn_sched_barrier(0);
        }
#undef SG_LOAD
    }
    __syncthreads();
}

#ifndef MK_PER_PHASE
#define MK_PER_PHASE 0
#endif
constexpr int PH_PER_LAYER = 9, NPH = 2 + DEPTH * PH_PER_LAYER + 1;

struct OffOrder : pg8::StaticOrder { int pm0;
    __device__ __forceinline__ bool next(int i, pg8::Unit& u) const { const bool ok = pg8::StaticOrder::next(i, u); u.pm += pm0; return ok; } };

__global__ void __launch_bounds__(NTHREADS, 2) fwd_kernel(Args args) {
    extern __shared__ __attribute__((aligned(16))) unsigned char lds_raw[];
    Frame F;
    F.lds = (LAS unsigned char*)lds_raw;
    F.tid = threadIdx.x; F.lane = F.tid & 63; F.wave = __builtin_amdgcn_readfirstlane(F.tid >> 6); F.G = gridDim.x; F.bid = blockIdx.x;
    F.ws = args.ws; F.out = args.out;
    unsigned char* ws = args.ws;
    if (F.tid == 0) {
#pragma unroll
        for (int i = 0; i < 25; ++i) *(LAS unsigned long long*)(F.lds + PTR_OFF + 8 * i) = (unsigned long long)args.in[i];
    }
    volatile LAS unsigned* MISC = (volatile LAS unsigned*)(F.lds + MISC_OFF);
    if (F.tid < 32) MISC[F.tid] = 0u;
    __syncthreads();
    XcdBarrier bar; bar.bar = (unsigned*)(ws + WS_CTL) + CW_BAR; bar.x = 0; bar.st = nullptr;
    if (!MK_PER_PHASE) bar = xcd_barrier_post((unsigned*)(ws + WS_CTL) + CW_BAR, MISC + 8);
    const int lo = args.ph_lo, hi = args.ph_hi;
    const int wave_s = __builtin_amdgcn_readfirstlane(threadIdx.x >> 6);
#ifndef PH_MASK
#define PH_MASK 0x7ff
#endif
#define KIND(k) ((k) == 0 ? 0 : ((k) == NPH - 1 ? 10 : 1 + ((k) - 1) % PH_PER_LAYER))
#define IN(k) (lo <= (k) && (k) < hi)
#ifndef SUB_TWICE
#define SUB_TWICE 0
#endif
#define SUBREPS(bit) for (int srep_ = 0; srep_ < 1 + ((SUB_TWICE >> (bit)) & 1); ++srep_)
#ifndef PH_TWICE
#define PH_TWICE 0
#endif
#define REPS(kind) for (int rep_ = 0, nrep_ = 1 + ((PH_TWICE >> (kind)) & 1); rep_ < nrep_; ++rep_)
#define GATE(p) ((PH_TWICE && rep_) ? (const float*)(ws + WS_CTL + 262144) : (p))
#define REP_SYNC() do { if (PH_TWICE && rep_ + 1 < nrep_ && !MK_PER_PHASE) xcd_barrier(bar, F.tid); } while (0)
#define PHASE_BEGIN() do { int l_; asm volatile("v_mbcnt_lo_u32_b32 %0, -1, 0\n\tv_mbcnt_hi_u32_b32 %0, -1, %0" : "=v"(l_)); F.lane = l_; F.wave = wave_s; F.tid = wave_s * 64 + l_; size_t z_ = 0; asm volatile("" : "+s"(z_)); unsigned char* w_ = args.ws + z_; F.ws = w_; ws = w_;     int g_ = gridDim.x, b_ = blockIdx.x; asm volatile("" : "+s"(g_), "+s"(b_)); F.G = g_; F.bid = b_; } while (0)
#define LANE_REFRESH() do { int l_; asm volatile("v_mbcnt_lo_u32_b32 %0, -1, 0\n\tv_mbcnt_hi_u32_b32 %0, -1, %0" : "=v"(l_)); F.lane = l_; F.tid = wave_s * 64 + l_; } while (0)
#define SEAM(k) do { if (!MK_PER_PHASE && IN(k) && IN((k) + 1)) xcd_barrier(bar, F.tid); } while (0)

    const bool G256 = (F.G == 256);
    if (((PH_MASK >> 0) & 1) && IN(0)) { REPS(0) { PHASE_BEGIN(); p0_prologue(F); REP_SYNC(); } SEAM(0); }
    if (IN(1)) { PHASE_BEGIN(); int r0, r1; share(MLAT, MALL, F.bid, F.G, r0, r1); norm_range(F, 0, 0, r0, r1); SEAM(1); }

    for (int L = 0; L < DEPTH; ++L) {
        const int pb = 2 + PH_PER_LAYER * L;
        const bool lastL = (L == DEPTH - 1);
        const bf16* wt = (const bf16*)(ws + WS_WT + (size_t)L * WT_LAYER);
        const float* modL = F.MOD() + (size_t)L * 9 * MODW;

        if (((PH_MASK >> 1) & 1) && IN(pb + 0)) { REPS(1) { PHASE_BEGIN();
            { pg8::Gemm g{F.HX(), (const bf16*)((const char*)wt + WT_IN), MCTX, PW, DM}; OffOrder S; S.init(MCTX, PW, F.G, F.bid); S.pm0 = 64;
              pg8::EpiInSplit E{F.Z(), PW, nullptr, F.KC(), F.VTC(), MLAT, CTXL};
              pg8::gemm_phase<pg8::EpiInSplit, OffOrder, true, true>(F.lds, g, S, E, F.tid); }
            int r0, r1;
            if (G256) { if (F.bid < 160) { r0 = 16 * F.bid; r1 = r0 + 16; } else { r0 = 2560 + 144 * (F.bid - 160); r1 = r0 + 144; if (r0 > MLAT) r0 = MLAT; if (r1 > MLAT) r1 = MLAT; } }
            else share(0, MLAT, F.bid, F.G, r0, r1);
            norm_range(F, L, 0, r0, r1);
            REP_SYNC(); }
            SEAM(pb + 0);
        }

        if (((PH_MASK >> 2) & 1) && IN(pb + 1)) { REPS(2) { PHASE_BEGIN();
            { pg8::Gemm g{F.HX(), (const bf16*)((const char*)wt + WT_IN), MLAT, PW, DM}; pg8::StaticOrder S; S.init(MLAT, PW, F.G, F.bid);
              pg8::EpiInSplit E{F.Z(), PW, F.QR(), F.KR(), F.VT(), 0, SEQ};
              pg8::gemm_phase<pg8::EpiInSplit, pg8::StaticOrder, true, true>(F.lds, g, S, E, F.tid); }
            __syncthreads();
            for (int u = 1024 + F.bid; u < 1152; u += F.G) lru_ab_unit(F, L, u);
            if (!G256 || F.bid >= 128) for (int wu = (G256 ? F.bid - 128 : F.bid) * NWAVES + F.wave; wu < 512; wu += (G256 ? F.G - 128 : F.G) * NWAVES) prep_unit(F, true, wu >> 6, (wu >> 2) & 15, wu & 3);
            REP_SYNC(); }
            SEAM(pb + 1);
        }

        if (((PH_MASK >> 3) & 1) && IN(pb + 2)) { REPS(3) { PHASE_BEGIN();
            if (G256 && !lastL) { const int nmine = F.bid >= 240 ? 2 : 4;
                for (int k = 0; k < nmine; ++k) lru_ab_unit(F, L, F.bid + 256 * k);
                if (F.bid >= 128 && F.bid < 144) lru_ab_unit(F, L, 240 + (F.bid - 128) + 256 * 3);
                if (F.bid >= 144 && F.bid < 160) lru_ab_unit(F, L, 240 + (F.bid - 144) + 256 * 2); }
            else for (int u = F.bid; u < 1024; u += F.G) lru_ab_unit(F, L, u);
            for (int wu = F.bid * NWAVES + F.wave; wu < 4096; wu += F.G * NWAVES) prep_unit(F, false, wu >> 9, (wu >> 5) & 15, wu & 31);
            if (!lastL) {
                for (int u = 1024 + F.bid; u < 1152; u += F.G) lru_d_unit(F, u);
                __syncthreads();
                LANE_REFRESH();
                const int xcd = F.bid & 7, slot = F.bid >> 3;
                attn_units<false, false>(F, L, G256 ? 1 : (256 - F.bid + F.G - 1) / F.G, [&](int i) { const int uu = G256 ? (xcd * 16 + (slot >> 1)) * 2 + (slot & 1) : F.bid + i * F.G; const int bh = uu >> 1;
                    return AtUnit{bh, 0, 0, MLAT + (bh >> 4) * CTXL + 128 * (uu & 1)}; }, nullptr);
                __syncthreads();
                LANE_REFRESH();
                if (F.G >= 16) { if (F.bid >= F.G - 16) sgu_unit(F, L, 128 + F.bid - (F.G - 16)); } else for (int uu = 128 + F.bid; uu < 144; uu += F.G) sgu_unit(F, L, uu);
            }
            REP_SYNC(); }
            SEAM(pb + 2);
        }

        if (((PH_MASK >> 4) & 1) && IN(pb + 3)) { REPS(4) { PHASE_BEGIN();
            if (!lastL) { pg8::Gemm g{F.MIX(), (const bf16*)((const char*)wt + WT_OUT), MCTX, DM, DM}; OffOrder S; S.init(MCTX, DM, F.G, F.bid); S.pm0 = 64;
              const bool in32 = (L == 0 && !(PH_TWICE && rep_)); pg8::EpiResGateB16 E{in32 ? F.inp(I_X) : nullptr, in32 ? F.inp(I_CTX) - (size_t)MLAT * DM : nullptr, F.X(), F.X(), GATE(modL + 2 * DM)};
              pg8::gemm_phase<pg8::EpiResGateB16, OffOrder, true, true>(F.lds, g, S, E, F.tid);
              __syncthreads(); }
            {
            SUBREPS(4) for (int u = F.bid; u < 1024; u += F.G) lru_d_unit(F, u);
            __syncthreads();
            LANE_REFRESH();
            SUBREPS(5) { if (F.G >= 128) { if (F.bid >= F.G - 128) sgu_unit(F, L, F.bid - (F.G - 128)); } else for (int uu = F.bid; uu < 128; uu += F.G) sgu_unit(F, L, uu); }
            __syncthreads();
            LANE_REFRESH();
            SUBREPS(2) { const bool grp = (F.G % 8 == 0); const int xg = grp ? (F.bid & 7) : 0; unsigned* qc = (unsigned*)(ws + WS_CTL) + CW_Q + (L * 8 + xg) * 64 + 2048 * (srep_ + rep_);
              attn_units<true, true>(F, L, grp ? 256 : 2048, [&](int n) {
                const int bl = n >> 4, bh = grp ? ((bl >> 1) * 16 + 2 * xg + (bl & 1)) : bl, sub = n & 15;
                return AtUnit{bh, 8 * (sub >> 2), 16 * (sub & 3), 0}; }, qc); }
            }
            REP_SYNC(); }
            SEAM(pb + 3);
        }

        if (((PH_MASK >> 5) & 1) && IN(pb + 4)) { REPS(5) { PHASE_BEGIN();
            { pg8::Gemm g{F.MIX(), (const bf16*)((const char*)wt + WT_OUT), MLAT, DM, DM}; pg8::StaticOrder S; S.init(MLAT, DM, F.G, F.bid);
              const bool in32 = (L == 0 && !(PH_TWICE && rep_)); pg8::EpiResGateB16 E{in32 ? F.inp(I_X) : nullptr, in32 ? F.inp(I_CTX) - (size_t)MLAT * DM : nullptr, F.X(), F.X(), GATE(modL + 2 * DM)};
              pg8::gemm_phase<pg8::EpiResGateB16, pg8::StaticOrder, true, true>(F.lds, g, S, E, F.tid); }
            if (!lastL) { int r0, r1; share(MLAT, MALL, F.bid, F.G, r0, r1); norm_range(F, L, 1, r0, r1); }
            REP_SYNC(); }
            SEAM(pb + 4);
        }

        if (((PH_MASK >> 6) & 1) && IN(pb + 5)) { REPS(6) { PHASE_BEGIN();
            int r0, r1;
            if (!lastL) { pg8::Gemm g{F.HX(), (const bf16*)((const char*)wt + WT_UP), MCTX, FU, DM}; OffOrder S; S.init(MCTX, FU, F.G, F.bid); S.pm0 = 64;
              pg8::EpiBf16<0> E{F.U(), FU, nullptr, 0, 0, 1.f};
              pg8::gemm_phase<pg8::EpiBf16<0>, OffOrder, true, true>(F.lds, g, S, E, F.tid);
              if (G256) { if (F.bid < 88) { r0 = 0; r1 = 0; } else share(0, MLAT, F.bid - 88, 168, r0, r1); } else share(0, MLAT, F.bid, F.G, r0, r1); }
            else share(0, MLAT, F.bid, F.G, r0, r1);
            norm_range(F, L, 1, r0, r1);
            REP_SYNC(); }
            SEAM(pb + 5);
        }

        if (((PH_MASK >> 7) & 1) && IN(pb + 6)) { REPS(7) { PHASE_BEGIN();
            { pg8::Gemm g{F.HX(), (const bf16*)((const char*)wt + WT_UP), MLAT, FU, DM}; pg8::StaticOrder S; S.init(MLAT, FU, F.G, F.bid);
              pg8::EpiBf16<0> E{F.U(), FU, nullptr, 0, 0, 1.f};
              pg8::gemm_phase<pg8::EpiBf16<0>, pg8::StaticOrder, true, true>(F.lds, g, S, E, F.tid); }
            if (!lastL) { if (G256) convgate_phase(F, L, MLAT, MALL, 192, 64); else convgate_phase(F, L, MLAT, MALL, 0, F.G); }
            REP_SYNC(); }
            SEAM(pb + 6);
        }

        if (((PH_MASK >> 8) & 1) && IN(pb + 7)) { REPS(8) { PHASE_BEGIN();
            if (!lastL) { pg8::Gemm g{F.ACT(), (const bf16*)((const char*)wt + WT_DN), MCTX, DM, FH}; OffOrder S; S.init(MCTX, DM, F.G, F.bid); S.pm0 = 64;
              pg8::EpiResGateB16 E{nullptr, nullptr, F.X(), F.X(), GATE(modL + 5 * DM)};
              pg8::gemm_phase<pg8::EpiResGateB16, OffOrder, true, true>(F.lds, g, S, E, F.tid); }
            SUBREPS(3) { if (G256 && !lastL) convgate_phase(F, L, 0, MLAT, 64, 192); else convgate_phase(F, L, 0, MLAT, 0, F.G); }
            REP_SYNC(); }
            SEAM(pb + 7);
        }

        if (((PH_MASK >> 9) & 1) && IN(pb + 8)) { REPS(9) { PHASE_BEGIN();
            { pg8::Gemm g{F.ACT(), (const bf16*)((const char*)wt + WT_DN), MLAT, DM, FH}; pg8::StaticOrder S; S.init(MLAT, DM, F.G, F.bid);
              pg8::EpiResGateB16 E{nullptr, nullptr, F.X(), F.X(), GATE(modL + 5 * DM)};
              pg8::gemm_phase<pg8::EpiResGateB16, pg8::StaticOrder, true, true>(F.lds, g, S, E, F.tid); }
            if (!lastL) { int r0, r1; share(MLAT, MALL, F.bid, F.G, r0, r1); norm_range(F, L + 1, 0, r0, r1); }
            REP_SYNC(); }
            SEAM(pb + 8);
        }
    }
    if (((PH_MASK >> 10) & 1) && IN(NPH - 1)) { PHASE_BEGIN(); final_norm_phase(F); }
#ifdef EXTRA_BARS
    if (!MK_PER_PHASE) for (int eb = 0; eb < EXTRA_BARS; ++eb) xcd_barrier(bar, F.tid);
#endif
#undef IN
#undef SEAM
}

extern "C" void kernel_launch(void* const* d_in, const int* in_sizes, int n_in, void* d_out, int out_size, void* d_ws, size_t ws_size, hipStream_t stream) {
    static int grid = 0;
    if (grid == 0) {
        if (n_in != 25 || out_size != MLAT * DM || ws_size < WS_END) { fprintf(stderr, "kernel_launch: unexpected shapes (n_in %d, out %d, ws %zu)\n", n_in, out_size, ws_size); grid = -1; return; }
        int dev = 0, cus = 0, per_cu = 0;
        if (hipGetDevice(&dev) != hipSuccess || hipDeviceGetAttribute(&cus, hipDeviceAttributeMultiprocessorCount, dev) != hipSuccess) { grid = -1; return; }
        if (hipFuncSetAttribute((const void*)fwd_kernel, hipFuncAttributeMaxDynamicSharedMemorySize, LDS_BYTES) != hipSuccess) { fprintf(stderr, "kernel_launch: hipFuncSetAttribute failed\n"); grid = -1; return; }
        if (hipOccupancyMaxActiveBlocksPerMultiprocessor(&per_cu, (const void*)fwd_kernel, NTHREADS, LDS_BYTES) != hipSuccess || per_cu < 1) { fprintf(stderr, "kernel_launch: occupancy query says %d\n", per_cu); }
        (void)hipGetLastError();
        grid = cus;
    }
    if (grid < 0) return;
    if (hipMemsetAsync((char*)d_ws + WS_CTL, 0, CTL_ZERO_BYTES, stream) != hipSuccess) return;
    Args a{};
    for (int i = 0; i < 25; ++i) a.in[i] = (const float*)d_in[i];
    a.out = (float*)d_out; a.ws = (unsigned char*)d_ws;
#if MK_PER_PHASE
    for (int p = 0; p < NPH; ++p) { a.ph_lo = p; a.ph_hi = p + 1; hipLaunchKernelGGL(fwd_kernel, dim3(grid), dim3(NTHREADS), LDS_BYTES, stream, a); }
#else
    a.ph_lo = 0; a.ph_hi = NPH;
    hipLaunchKernelGGL(fwd_kernel, dim3(grid), dim3(NTHREADS), LDS_BYTES, stream, a);
#endif
    const hipError_t le = hipPeekAtLastError();
    if (le != hipSuccess) fprintf(stderr, "kernel_launch: launch failed: %s\n", hipGetErrorName(le));
}
```
